# Optimizing an MI355X kernel written in HIP

```python
import jax, jax.numpy as jnp
from jax import lax
import numpy as np

D_MODEL = 1024
BATCH = 4
SEQ = 4096
DEPTH = 2

D_MIX = D_MODEL
HEAD_DIM = 64
SGU_DIM = 3 * D_MIX // 8
SGU_HEADS = SGU_DIM // HEAD_DIM
CONV_DIM = 3 * D_MIX // 8
POOL_DIM = D_MIX - SGU_DIM - CONV_DIM
POOL_WINDOWS = (2, 4, 8, 16)
POOL_GROUPS = len(POOL_WINDOWS)
POOL_GROUP_DIM = POOL_DIM // POOL_GROUPS
CHUNK = 128
CONV_WIDTH = 31
D_IN = 2 * SGU_DIM + 2 * CONV_DIM + POOL_DIM
D_FF = 2816
FFN_RESIDUAL_WEIGHT = 0.5
EPS = 1e-6

kernel_name = "hybrid_macaron_sgu_conv_pool"


def rms_norm(x, g):
    xf = x.astype(jnp.float32)
    y = xf * lax.rsqrt(jnp.mean(xf * xf, axis=-1, keepdims=True) + EPS)
    return (y * g.astype(jnp.float32)).astype(x.dtype)


def layer_norm(x, g, b):
    xf = x.astype(jnp.float32)
    mu = jnp.mean(xf, axis=-1, keepdims=True)
    xc = xf - mu
    var = jnp.mean(xc * xc, axis=-1, keepdims=True)
    y = xc * lax.rsqrt(var + EPS) * g.astype(jnp.float32) + b.astype(jnp.float32)
    return y.astype(x.dtype)


def swiglu_ffn(h, w_gate, w_up, w_down):
    return (jax.nn.silu(h @ w_gate) * (h @ w_up)) @ w_down


def spatial_gating(u, v, ln_g, ln_b, w_s, b_s):
    bsz, t_len, _ = v.shape
    v = layer_norm(v, ln_g, ln_b)
    causal = jnp.tril(jnp.ones((CHUNK, CHUNK), dtype=bool))
    w = jnp.where(causal[None], w_s, jnp.zeros_like(w_s))
    vc = v.reshape(bsz, t_len // CHUNK, CHUNK, SGU_HEADS, HEAD_DIM)
    mixed = jnp.einsum('hpq,bnqhc->bnphc', w, vc) + b_s.T[None, None, :, :, None]
    return u * mixed.reshape(bsz, t_len, SGU_DIM)


def conformer_conv(val, gate, conv_w, conv_b, ln_g, ln_b):
    h = val * jax.nn.sigmoid(gate)
    h = lax.conv_general_dilated(
        h, conv_w[:, None, :].astype(h.dtype), window_strides=(1,),
        padding=((CONV_WIDTH - 1, 0),),
        dimension_numbers=('NWC', 'WIO', 'NWC'),
        feature_group_count=CONV_DIM) + conv_b
    h = layer_norm(h, ln_g, ln_b)
    return jax.nn.silu(h)


def multiscale_pool(p, pool_w, pool_scale):
    bsz, t_len, _ = p.shape
    pg = p.reshape(bsz, t_len, POOL_GROUPS, POOL_GROUP_DIM)
    csum = jnp.cumsum(pg.astype(jnp.float32), axis=1)
    pos = jnp.arange(1, t_len + 1, dtype=jnp.float32)
    means = []
    for g, w in enumerate(POOL_WINDOWS):
        cg = csum[:, :, g]
        lagged = jnp.pad(cg, ((0, 0), (w, 0), (0, 0)))[:, :t_len]
        count = jnp.minimum(pos, jnp.float32(w))[None, :, None]
        means.append((cg - lagged) / count)
    pooled = jnp.stack(means, axis=2).astype(p.dtype) - pg
    mixed = jnp.einsum('btgc,gcd->btgd', pooled, pool_w).reshape(bsz, t_len, POOL_DIM)
    return mixed * pool_scale


def hybrid_mixer(h, w_in, sgu_ln_g, sgu_ln_b, w_spatial, b_spatial,
                 conv_w, conv_b, conv_ln_g, conv_ln_b, pool_w, pool_scale, w_out):
    z = h @ w_in
    s1 = SGU_DIM
    s2 = 2 * SGU_DIM
    s3 = s2 + CONV_DIM
    s4 = s3 + CONV_DIM
    a_u, a_v, b_val, b_gate, c_in = z[..., :s1], z[..., s1:s2], z[..., s2:s3], z[..., s3:s4], z[..., s4:]
    a = spatial_gating(jax.nn.gelu(a_u, approximate=False), jax.nn.gelu(a_v, approximate=False),
                       sgu_ln_g, sgu_ln_b, w_spatial, b_spatial)
    b = conformer_conv(b_val, b_gate, conv_w, conv_b, conv_ln_g, conv_ln_b)
    c = multiscale_pool(c_in, pool_w, pool_scale)
    return jnp.concatenate([a, b, c], axis=-1) @ w_out


def setup_inputs(seed: int = 0) -> dict:
    key = jax.random.key(seed)
    ks = jax.random.split(key, 24)
    f32 = jnp.float32

    def nrm(k, shape, scale):
        return jax.random.normal(k, shape, f32) * scale

    L, D, F = DEPTH, D_MODEL, D_FF
    return {
        "x": jax.random.normal(ks[0], (BATCH, SEQ, D), f32),
        "ffn1_norm": 1.0 + nrm(ks[1], (L, D), 0.02),
        "ffn1_w_gate": nrm(ks[2], (L, D, F), D ** -0.5),
        "ffn1_w_up": nrm(ks[3], (L, D, F), D ** -0.5),
        "ffn1_w_down": nrm(ks[4], (L, F, D), F ** -0.5),
        "mix_norm": 1.0 + nrm(ks[5], (L, D), 0.02),
        "w_in": nrm(ks[6], (L, D, D_IN), D ** -0.5),
        "sgu_ln_g": 1.0 + nrm(ks[7], (L, SGU_DIM), 0.02),
        "sgu_ln_b": nrm(ks[8], (L, SGU_DIM), 0.02),
        "w_spatial": nrm(ks[9], (L, SGU_HEADS, CHUNK, CHUNK), CHUNK ** -0.5),
        "b_spatial": 1.0 + nrm(ks[10], (L, SGU_HEADS, CHUNK), 0.02),
        "conv_w": nrm(ks[11], (L, CONV_WIDTH, CONV_DIM), CONV_WIDTH ** -0.5),
        "conv_b": nrm(ks[12], (L, CONV_DIM), 0.02),
        "conv_ln_g": 1.0 + nrm(ks[13], (L, CONV_DIM), 0.02),
        "conv_ln_b": nrm(ks[14], (L, CONV_DIM), 0.02),
        "pool_w": nrm(ks[15], (L, POOL_GROUPS, POOL_GROUP_DIM, POOL_GROUP_DIM), POOL_GROUP_DIM ** -0.5),
        "pool_scale": 1.0 + nrm(ks[16], (L, POOL_DIM), 0.1),
        "w_out": nrm(ks[17], (L, D_MIX, D), D_MIX ** -0.5),
        "ffn2_norm": 1.0 + nrm(ks[18], (L, D), 0.02),
        "ffn2_w_gate": nrm(ks[19], (L, D, F), D ** -0.5),
        "ffn2_w_up": nrm(ks[20], (L, D, F), D ** -0.5),
        "ffn2_w_down": nrm(ks[21], (L, F, D), F ** -0.5),
        "final_norm": 1.0 + nrm(ks[22], (D,), 0.02),
    }


def reference(x, ffn1_norm, ffn1_w_gate, ffn1_w_up, ffn1_w_down, mix_norm, w_in,
              sgu_ln_g, sgu_ln_b, w_spatial, b_spatial, conv_w, conv_b, conv_ln_g, conv_ln_b,
              pool_w, pool_scale, w_out, ffn2_norm, ffn2_w_gate, ffn2_w_up, ffn2_w_down,
              final_norm):
    for l in range(DEPTH):
        x = x + FFN_RESIDUAL_WEIGHT * swiglu_ffn(rms_norm(x, ffn1_norm[l]),
                                                 ffn1_w_gate[l], ffn1_w_up[l], ffn1_w_down[l])
        x = x + hybrid_mixer(rms_norm(x, mix_norm[l]), w_in[l],
                             sgu_ln_g[l], sgu_ln_b[l], w_spatial[l], b_spatial[l],
                             conv_w[l], conv_b[l], conv_ln_g[l], conv_ln_b[l],
                             pool_w[l], pool_scale[l], w_out[l])
        x = x + FFN_RESIDUAL_WEIGHT * swiglu_ffn(rms_norm(x, ffn2_norm[l]),
                                                 ffn2_w_gate[l], ffn2_w_up[l], ffn2_w_down[l])
    return rms_norm(x, final_norm)
```

```cpp
#include <hip/hip_runtime.h>
#include <hip/hip_cooperative_groups.h>
#include <cstdio>
#include <cstdint>
namespace cg = cooperative_groups;
namespace pg8 {
#define PG8_LAS __attribute__((address_space(3)))
typedef unsigned short bf16_t;
typedef short bf16x8 __attribute__((ext_vector_type(8)));
typedef float f32x4 __attribute__((ext_vector_type(4)));
typedef unsigned u32x4 __attribute__((ext_vector_type(4)));
constexpr int BM = 256, BK = 64, HALF = 128, HTB = HALF * BK * 2  , STAGE_BYTES = 8 * HTB, NXCD = 8, WGM = 8;

__host__ __device__ __forceinline__ int lds_byte(int r, int c) { const int st = (r >> 4) * 2 + (c >> 5), rr = r & 15, cc = c & 31, ob = rr * 64 + cc * 2; return st * 1024 + (ob ^ (((ob >> 9) & 1) << 5)); }
__host__ __device__ __forceinline__ void stage_rc(int b, int& R, int& C) { const int st = b / 1024, sb = b % 1024, swz = sb ^ (((sb >> 9) & 1) << 5); R = (st >> 1) * 16 + swz / 64; C = (st & 1) * 32 + (swz % 64) / 2; }
__host__ __device__ __forceinline__ int perm32(int rho) { const int n = rho >> 4, i = rho & 15; return 8 * (i >> 2) + 4 * n + (i & 3); }

struct Unit { int pm, pn; };
struct Gemm { const bf16_t* A; const bf16_t* Bt; int M, N, K; };

struct StaticOrder {
    int nM, nN, nwg, G, c;
    __host__ __device__ void init(int M, int N, int G_, int c_) { nM = M / BM; nN = N / BM; nwg = nM * nN; G = G_; c = c_; }
    __host__ __device__ bool next(int i, Unit& u) const {
        const long L = (long)i * G + c; if (L >= nwg) return false;
        int wgid = (int)L; { const int q = nwg / NXCD, r = nwg % NXCD, xcd = wgid % NXCD, off = wgid / NXCD; wgid = (xcd < r ? xcd * (q + 1) : r * (q + 1) + (xcd - r) * q) + off; }
        const int nig = WGM * nN, gid = wgid / nig, fm = gid * WGM, gsz = (nM - fm) < WGM ? (nM - fm) : WGM;
        u.pm = fm + ((wgid % nig) % gsz); u.pn = (wgid % nig) / gsz; return true;
    }
    __device__ __forceinline__ void a_ready(const Unit&) const {}
    __device__ __forceinline__ void done(const Unit&) const {}
};

__device__ __forceinline__ unsigned cvt_pk_bf16(float lo, float hi) { unsigned r; asm volatile("v_cvt_pk_bf16_f32 %0, %1, %2" : "=v"(r) : "v"(lo), "v"(hi)); return r; }
typedef float f32x2 __attribute__((ext_vector_type(2)));
__device__ __forceinline__ f32x2 gelu_pk(f32x2 v) {
    const f32x2 av = __builtin_elementwise_abs(v), d = av * 0.2316418882f + 1.0f;
    f32x2 t; t.x = __builtin_amdgcn_rcpf(d.x); t.y = __builtin_amdgcn_rcpf(d.y);
    f32x2 q = t * 0.5307027145f + (-0.7265760135f); q = q * t + 0.7107068705f; q = q * t + (-0.142248368f); q = q * t + 0.127414796f; q = q * t;
    const f32x2 s = (v * v) * (-0.72134752044f);
    f32x2 e; e.x = __builtin_amdgcn_exp2f(s.x); e.y = __builtin_amdgcn_exp2f(s.y);
    const f32x2 m = v * (q * e), r = v - m;
    f32x2 o; o.x = v.x < 0.f ? m.x : r.x; o.y = v.y < 0.f ? m.y : r.y; return o;
}

__device__ __forceinline__ float row_rstd(const float* ssq, int row, int fq) {
    const f32x4 p = *(const f32x4*)(ssq + (size_t)row * 16 + 4 * fq);
    float s = (p[0] + p[1]) + (p[2] + p[3]);
    s += __shfl_xor(s, 16); s += __shfl_xor(s, 32);
    return __builtin_amdgcn_rsqf(s * (1.0f / 1024.0f) + 1e-6f);
}
__device__ __forceinline__ float silu_f(float g) { return g * __builtin_amdgcn_rcpf(1.0f + __builtin_amdgcn_exp2f(g * -1.44269504089f)); }
__device__ __forceinline__ float sigm_f(float g) { return __builtin_amdgcn_rcpf(1.0f + __builtin_amdgcn_exp2f(g * -1.44269504089f)); }

struct EpiSwiGLU {
    static constexpr bool PERM = true, AFTER_DRAIN = false;
    bf16_t* O; int ldo; const float* ssq;
    __device__ __forceinline__ void operator()(const f32x4 (&acc)[2][2][4][2], const Unit& u, int wr, int wc, int fr, int fq) const {
        const int row0 = u.pm * BM + wr * 64 + fr, col0 = u.pn * HALF + wc * 32 + 8 * fq;
#pragma unroll
        for (int ai = 0; ai < 2; ++ai)
#pragma unroll
            for (int m = 0; m < 4; ++m) {
                const int row = row0 + ai * HALF + m * 16;
                const float rs = row_rstd(ssq, row, fq);
                const f32x4 g0 = acc[ai][0][m][0] * rs, g1 = acc[ai][0][m][1] * rs, u0 = acc[ai][1][m][0] * rs, u1 = acc[ai][1][m][1] * rs;
                u32x4 w;
                w.x = cvt_pk_bf16(silu_f(g0[0]) * u0[0], silu_f(g0[1]) * u0[1]); w.y = cvt_pk_bf16(silu_f(g0[2]) * u0[2], silu_f(g0[3]) * u0[3]);
                w.z = cvt_pk_bf16(silu_f(g1[0]) * u1[0], silu_f(g1[1]) * u1[1]); w.w = cvt_pk_bf16(silu_f(g1[2]) * u1[2], silu_f(g1[3]) * u1[3]);
                *(u32x4*)(O + (size_t)row * ldo + col0) = w;
            }
    }
};

struct EpiRes {
    static constexpr bool PERM = true, AFTER_DRAIN = false;
    const float* base; float* out; bf16_t* xb; float* ssq; float w;
    __device__ __forceinline__ void operator()(const f32x4 (&acc)[2][2][4][2], const Unit& u, int wr, int wc, int fr, int fq) const {
        const int row0 = u.pm * BM + wr * 64 + fr, col0 = u.pn * BM + wc * 32 + 8 * fq;
#pragma unroll
        for (int ai = 0; ai < 2; ++ai)
#pragma unroll
            for (int m = 0; m < 4; ++m) {
                const int row = row0 + ai * HALF + m * 16; float q = 0.f;
#pragma unroll
                for (int bj = 0; bj < 2; ++bj) {
                    const size_t off = (size_t)row * 1024 + col0 + bj * HALF;
                    const f32x4 b0 = *(const f32x4*)(base + off), b1 = *(const f32x4*)(base + off + 4);
                    const f32x4 v0 = b0 + acc[ai][bj][m][0] * w, v1 = b1 + acc[ai][bj][m][1] * w;
                    *(f32x4*)(out + off) = v0; *(f32x4*)(out + off + 4) = v1;
                    u32x4 pk; pk.x = cvt_pk_bf16(v0[0], v0[1]); pk.y = cvt_pk_bf16(v0[2], v0[3]); pk.z = cvt_pk_bf16(v1[0], v1[1]); pk.w = cvt_pk_bf16(v1[2], v1[3]);
                    *(u32x4*)(xb + off) = pk;
                    q += (v0[0] * v0[0] + v0[1] * v0[1]) + (v0[2] * v0[2] + v0[3] * v0[3]) + (v1[0] * v1[0] + v1[1] * v1[1]) + (v1[2] * v1[2] + v1[3] * v1[3]);
                }
                q += __shfl_xor(q, 16); q += __shfl_xor(q, 32);
                if (fq == 0) ssq[(size_t)row * 16 + u.pn * 4 + wc] = q;
                if (m & 1) asm volatile("" ::: "memory");
            }
    }
};

struct EpiWin {
    static constexpr bool PERM = true, AFTER_DRAIN = false;
    bf16_t* Z; int ldz; const float* ssq;
    __device__ __forceinline__ void operator()(const f32x4 (&acc)[2][2][4][2], const Unit& u, int wr, int wc, int fr, int fq) const {
        const int row0 = u.pm * BM + wr * 64 + fr, cw = wc * 32 + 8 * fq;
#pragma unroll
        for (int ai = 0; ai < 2; ++ai)
#pragma unroll
            for (int m = 0; m < 4; ++m) {
                const int row = row0 + ai * HALF + m * 16;
                const float rs = row_rstd(ssq, row, fq);
                bf16_t* zr = Z + (size_t)row * ldz;
                if (u.pn >= 3 && u.pn < 6) {
                    const f32x4 a0 = acc[ai][0][m][0] * rs, a1 = acc[ai][0][m][1] * rs, g0 = acc[ai][1][m][0] * rs, g1 = acc[ai][1][m][1] * rs;
                    u32x4 pk;
                    pk.x = cvt_pk_bf16(a0[0] * sigm_f(g0[0]), a0[1] * sigm_f(g0[1])); pk.y = cvt_pk_bf16(a0[2] * sigm_f(g0[2]), a0[3] * sigm_f(g0[3]));
                    pk.z = cvt_pk_bf16(a1[0] * sigm_f(g1[0]), a1[1] * sigm_f(g1[1])); pk.w = cvt_pk_bf16(a1[2] * sigm_f(g1[2]), a1[3] * sigm_f(g1[3]));
                    *(u32x4*)(zr + 768 + 128 * (u.pn - 3) + cw) = pk;
                } else {
                    const int cbase = (u.pn < 3) ? 256 * u.pn : 1152;
#pragma unroll
                    for (int bj = 0; bj < 2; ++bj) {
                        f32x4 v0 = acc[ai][bj][m][0] * rs, v1 = acc[ai][bj][m][1] * rs;
                        if (u.pn < 3) { const f32x2 a = gelu_pk((f32x2){v0[0], v0[1]}), b = gelu_pk((f32x2){v0[2], v0[3]}), c = gelu_pk((f32x2){v1[0], v1[1]}), d = gelu_pk((f32x2){v1[2], v1[3]});
                            v0 = (f32x4){a.x, a.y, b.x, b.y}; v1 = (f32x4){c.x, c.y, d.x, d.y}; }
                        u32x4 pk; pk.x = cvt_pk_bf16(v0[0], v0[1]); pk.y = cvt_pk_bf16(v0[2], v0[3]); pk.z = cvt_pk_bf16(v1[0], v1[1]); pk.w = cvt_pk_bf16(v1[2], v1[3]);
                        *(u32x4*)(zr + cbase + bj * HALF + cw) = pk;
                    }
                }
            }
    }
};

template <class Epi, class Sched, bool ALIGN_EPI = false, bool SP2 = false>
__device__ __forceinline__ void gemm_phase(PG8_LAS unsigned char* lds, const Gemm g, const Sched& S, const Epi& E) {
    int tid = threadIdx.x; asm volatile("" : "+v"(tid));
    const int wid = __builtin_amdgcn_readfirstlane(tid >> 6), lane = tid & 63, wr = wid >> 2, wc = wid & 3, fr = lane & 15, fq = lane >> 4;
    const int K = g.K, nt = K / BK;
    unsigned voffA[2], voffB[2];
#pragma unroll
    for (int i = 0; i < 2; ++i) { int R, C; stage_rc(tid * 16 + i * 8192, R, C); const int Rb = Epi::PERM ? ((R & ~31) + perm32(R & 31)) : R;
        voffA[i] = (unsigned)(R * K + C) * 2u; voffB[i] = (unsigned)(Rb * K + C) * 2u; }
    const size_t kstep = (size_t)(BK * 2);
    const size_t hstep = (size_t)HALF * K * 2;
    const size_t tstep = 2 * hstep;
    const unsigned ldsw = (unsigned)wid * 1024u;
    const int aoff = lds_byte(wr * 64 + fr, fq * 8), boff = lds_byte(wc * 32 + fr, fq * 8);
#define PG8_SA(b, h) (((b) * 2 + (h)) * HTB)
#define PG8_SB(b, h) ((4 + (b) * 2 + (h)) * HTB)
#define PG8_STAGE(bufoff, gbase, voff) do { _Pragma("unroll") for (int _i = 0; _i < 2; ++_i) \
        __builtin_amdgcn_global_load_lds((const unsigned*)((const char*)(gbase) + (voff)[_i]), (PG8_LAS unsigned*)(lds + (bufoff) + ldsw + _i * 8192), 16, 0, 0); } while (0)
#define PG8_LDA(dst, b, h) do { _Pragma("unroll") for (int m = 0; m < 4; ++m) _Pragma("unroll") for (int k = 0; k < 2; ++k) dst[m][k] = *(const PG8_LAS bf16x8*)(lds + PG8_SA(b, h) + aoff + m * 2048 + k * 1024); } while (0)
#define PG8_LDB(dst, b, h) do { _Pragma("unroll") for (int n = 0; n < 2; ++n) _Pragma("unroll") for (int k = 0; k < 2; ++k) dst[n][k] = *(const PG8_LAS bf16x8*)(lds + PG8_SB(b, h) + boff + n * 2048 + k * 1024); } while (0)
#define PG8_MMA(ai, bj, At, Bt) do { __builtin_amdgcn_s_setprio(1); _Pragma("unroll") for (int m = 0; m < 4; ++m) _Pragma("unroll") for (int n = 0; n < 2; ++n) _Pragma("unroll") for (int k = 0; k < 2; ++k) \
        acc[ai][bj][m][n] = __builtin_amdgcn_mfma_f32_16x16x32_bf16(Bt[n][k], At[m][k], acc[ai][bj][m][n], 0, 0, 0); __builtin_amdgcn_s_setprio(0); } while (0)
#define PG8_WAIT_V(n) asm volatile("s_waitcnt vmcnt(" #n ")" ::: "memory")
#define PG8_WAIT_L(n) asm volatile("s_waitcnt lgkmcnt(" #n ")" ::: "memory")
#define PG8_BAR __builtin_amdgcn_s_barrier()
#define PG8_SCHED __builtin_amdgcn_sched_barrier(0)
    Unit cur, nxt; int ui = 0;
    if (!S.next(0, cur)) return;
    f32x4 acc[2][2][4][2];
#pragma unroll
    for (int a = 0; a < 2; ++a)
#pragma unroll
        for (int b = 0; b < 2; ++b)
#pragma unroll
            for (int m = 0; m < 4; ++m)
#pragma unroll
                for (int n = 0; n < 2; ++n) acc[a][b][m][n] = (f32x4){0.f, 0.f, 0.f, 0.f};
    bf16x8 At[4][2], B0[2][2], B1[2][2];
    const char* cA = (const char*)g.A + (size_t)cur.pm * tstep; const char* cB = (const char*)g.Bt + (size_t)cur.pn * tstep;
    S.a_ready(cur);
    if constexpr (SP2) {
        PG8_STAGE(PG8_SB(0, 0), cB, voffB); PG8_STAGE(PG8_SB(0, 1), cB + hstep, voffB); PG8_STAGE(PG8_SA(0, 0), cA, voffA); PG8_STAGE(PG8_SA(0, 1), cA + hstep, voffA);
        if (wr == 1) PG8_BAR;
        PG8_WAIT_V(2); PG8_BAR;
        PG8_STAGE(PG8_SB(1, 0), cB + kstep, voffB); PG8_STAGE(PG8_SA(1, 0), cA + kstep, voffA); PG8_STAGE(PG8_SB(1, 1), cB + hstep + kstep, voffB);
        PG8_WAIT_V(6); PG8_BAR;
    } else {
        PG8_STAGE(PG8_SB(0, 0), cB, voffB); PG8_STAGE(PG8_SA(0, 0), cA, voffA); PG8_STAGE(PG8_SB(0, 1), cB + hstep, voffB); PG8_STAGE(PG8_SA(0, 1), cA + hstep, voffA);
        if (wr == 1) PG8_BAR;
        PG8_WAIT_V(4); PG8_BAR;
        PG8_STAGE(PG8_SB(1, 0), cB + kstep, voffB); PG8_STAGE(PG8_SA(1, 0), cA + kstep, voffA); PG8_STAGE(PG8_SB(1, 1), cB + hstep + kstep, voffB);
        PG8_WAIT_V(6); PG8_BAR;
    }
    for (;;) {
        const bool has_next = S.next(ui + 1, nxt);
        const char* nA = has_next ? (const char*)g.A + (size_t)nxt.pm * tstep : cA; const char* nB = has_next ? (const char*)g.Bt + (size_t)nxt.pn * tstep : cB;
        for (int t = 0; t < nt; t += 2) {
            const bool last = (t == nt - 2);
            const char* a1 = cA + (size_t)(t + 1) * kstep;
            const char* a2 = last ? nA : cA + (size_t)(t + 2) * kstep; const char* b2 = last ? nB : cB + (size_t)(t + 2) * kstep;
            const char* a3 = a2 + kstep; const char* b3 = b2 + kstep;
            if (last && has_next) S.a_ready(nxt);
            if constexpr (SP2) {
            PG8_LDB(B0, 0, 0); PG8_LDB(B1, 0, 1); PG8_SCHED; PG8_LDA(At, 0, 0); PG8_STAGE(PG8_SA(1, 1), a1 + hstep, voffA);
            PG8_WAIT_V(8); PG8_WAIT_L(0); PG8_BAR; PG8_MMA(0, 0, At, B0); PG8_MMA(0, 1, At, B1); PG8_BAR; PG8_SCHED;
            PG8_LDA(At, 0, 1); PG8_STAGE(PG8_SB(0, 0), b2, voffB); PG8_STAGE(PG8_SB(0, 1), b2 + hstep, voffB); PG8_STAGE(PG8_SA(0, 0), a2, voffA);
            PG8_WAIT_V(8); PG8_WAIT_L(0); PG8_BAR; PG8_MMA(1, 0, At, B0); PG8_MMA(1, 1, At, B1); PG8_BAR; PG8_SCHED;
            PG8_LDB(B0, 1, 0); PG8_LDB(B1, 1, 1); PG8_SCHED; PG8_LDA(At, 1, 0); PG8_STAGE(PG8_SA(0, 1), a2 + hstep, voffA);
            PG8_WAIT_V(8); PG8_WAIT_L(0); PG8_BAR; PG8_MMA(0, 0, At, B0); PG8_MMA(0, 1, At, B1); PG8_BAR; PG8_SCHED;
            PG8_LDA(At, 1, 1); PG8_STAGE(PG8_SB(1, 0), b3, voffB); PG8_STAGE(PG8_SB(1, 1), b3 + hstep, voffB); PG8_STAGE(PG8_SA(1, 0), a3, voffA);
            PG8_WAIT_V(8); PG8_WAIT_L(0); PG8_BAR; PG8_MMA(1, 0, At, B0); PG8_MMA(1, 1, At, B1); PG8_BAR; PG8_SCHED;
            } else {
            PG8_LDB(B0, 0, 0); PG8_SCHED; PG8_LDA(At, 0, 0); PG8_STAGE(PG8_SA(1, 1), a1 + hstep, voffA);
            PG8_WAIT_L(8); PG8_BAR; PG8_WAIT_L(0); PG8_MMA(0, 0, At, B0); PG8_BAR; PG8_SCHED;
            PG8_LDB(B1, 0, 1); PG8_STAGE(PG8_SB(0, 0), b2, voffB);
            PG8_BAR; PG8_WAIT_L(0); PG8_MMA(0, 1, At, B1); PG8_BAR;
            PG8_LDA(At, 0, 1); PG8_STAGE(PG8_SA(0, 0), a2, voffA);
            PG8_BAR; PG8_WAIT_L(0); PG8_MMA(1, 0, At, B0); PG8_BAR; PG8_SCHED;
            PG8_STAGE(PG8_SB(0, 1), b2 + hstep, voffB);
            PG8_WAIT_V(6); PG8_BAR; PG8_MMA(1, 1, At, B1); PG8_BAR;
            PG8_LDB(B0, 1, 0); PG8_SCHED; PG8_LDA(At, 1, 0); PG8_STAGE(PG8_SA(0, 1), a2 + hstep, voffA);
            PG8_WAIT_L(8); PG8_BAR; PG8_WAIT_L(0); PG8_MMA(0, 0, At, B0); PG8_BAR; PG8_SCHED;
            PG8_LDB(B1, 1, 1); PG8_STAGE(PG8_SB(1, 0), b3, voffB);
            PG8_BAR; PG8_WAIT_L(0); PG8_MMA(0, 1, At, B1); PG8_BAR;
            PG8_LDA(At, 1, 1); PG8_STAGE(PG8_SA(1, 0), a3, voffA);
            PG8_BAR; PG8_WAIT_L(0); PG8_MMA(1, 0, At, B0); PG8_BAR; PG8_SCHED;
            PG8_STAGE(PG8_SB(1, 1), b3 + hstep, voffB);
            PG8_WAIT_V(6); PG8_BAR; PG8_MMA(1, 1, At, B1); PG8_BAR;
            }
        }
        if constexpr (ALIGN_EPI) { if (wr == 0) PG8_BAR; }
        if constexpr (!Epi::AFTER_DRAIN) { E(acc, cur, wr, wc, fr, fq); S.done(cur); }
        if (!has_next) break;
#pragma unroll
        for (int a = 0; a < 2; ++a)
#pragma unroll
            for (int b = 0; b < 2; ++b)
#pragma unroll
                for (int m = 0; m < 4; ++m)
#pragma unroll
                    for (int n = 0; n < 2; ++n) acc[a][b][m][n] = (f32x4){0.f, 0.f, 0.f, 0.f};
        cur = nxt; cA = nA; cB = nB; ++ui;
        if constexpr (ALIGN_EPI) { if (wr == 1) PG8_BAR; }
    }
    PG8_WAIT_V(0);
    if constexpr (!ALIGN_EPI) { if (wr == 0) PG8_BAR; }
    PG8_BAR;
    if constexpr (Epi::AFTER_DRAIN) { E.fused(acc, cur, wr, wc, fr, fq, lds, wid, lane); S.done(cur); }
#undef PG8_SA
#undef PG8_SB
#undef PG8_STAGE
#undef PG8_LDA
#undef PG8_LDB
#undef PG8_MMA
#undef PG8_WAIT_V
#undef PG8_WAIT_L
#undef PG8_BAR
#undef PG8_SCHED
}
}

#ifndef MK_PER_PHASE
#define MK_PER_PHASE 0
#endif
#define LAS __attribute__((address_space(3)))
using pg8::bf16_t; using pg8::f32x4; using pg8::u32x4; using pg8::bf16x8;
typedef unsigned u32x2 __attribute__((ext_vector_type(2)));

constexpr int M = 16384, SEQ = 4096, D = 1024, FF = 2816, DIN = 1792, NLAYER = 2;
constexpr int ZLD = 1408;
constexpr float EPS = 1e-6f;
constexpr int NPHASE = 16;
constexpr size_t MiB = 1u << 20;
constexpr size_t WS_SSQ = 1 * MiB, WS_W = 2 * MiB, WS_XB = 80 * MiB, WS_H = 112 * MiB, WS_Z = 112 * MiB, WS_Y = 156 * MiB;
constexpr size_t W_GU1 = 0, W_D1 = 11534336, W_IN = 17301504, W_OUT = 20971520, W_GU2 = 23068672, W_D2 = 34603008, W_LAYER = 40370176;
static_assert(WS_W + 2 * W_LAYER <= WS_XB && WS_Z + (size_t)M * ZLD * 2 <= WS_Y && WS_Y + (size_t)M * D * 2 <= WS_H + (size_t)M * FF * 2 && WS_H + (size_t)M * FF * 2 <= 256 * MiB, "ws map");
constexpr int LDS_BYTES = 147456;
constexpr int VT_LD = 136, PW_LD = 72;
constexpr int L_VT = 0, L_CW = 52224, L_PW = L_CW + 32 * 384 * 4;
static_assert(L_PW + 4 * 64 * PW_LD * 2 <= LDS_BYTES, "lds map");

__device__ __forceinline__ unsigned f2bf(float f) { unsigned u = __builtin_bit_cast(unsigned, f); return (u + 0x7fffu + ((u >> 16) & 1u)) >> 16; }
__device__ __forceinline__ unsigned pk2(float lo, float hi) { return f2bf(lo) | (f2bf(hi) << 16); }
__device__ __forceinline__ float bf_lo(unsigned w) { return __uint_as_float(w << 16); }
__device__ __forceinline__ float bf_hi(unsigned w) { return __uint_as_float(w & 0xffff0000u); }
__device__ __forceinline__ float wave_sum(float v) {
#pragma unroll
    for (int o = 1; o < 64; o <<= 1) v += __shfl_xor(v, o);
    return v;
}
__device__ __forceinline__ void ld6(const bf16_t* p, float (&v)[6]) {
    const unsigned* q = (const unsigned*)p; const unsigned a = q[0], b = q[1], c = q[2];
    v[0] = bf_lo(a); v[1] = bf_hi(a); v[2] = bf_lo(b); v[3] = bf_hi(b); v[4] = bf_lo(c); v[5] = bf_hi(c);
}

__device__ __forceinline__ int dst_row(int mode, int c) {
    if (mode == 0) return c;
    if (mode == 1) return 256 * (c >> 7) + (c & 127);
    if (mode == 2) return 256 * (c >> 7) + 128 + (c & 127);
    if (c < 768 || c >= 1536) return c;
    if (c < 1152) { const int j = c - 768; return 768 + 256 * (j >> 7) + (j & 127); }
    { const int j = c - 1152; return 768 + 256 * (j >> 7) + 128 + (j & 127); }
}
__device__ __forceinline__ void p0_transpose_item(const float* W, int K, int N, bf16_t* WT, int mode, const float* gk, LAS float* scr, int item, int lane) {
    const int nblk = N / 32, kb = item / nblk, nb = item % nblk, k0 = 64 * kb, n0 = 32 * nb;
#pragma unroll 8
    for (int i = 0; i < 32; ++i) { const int kk = 2 * i + (lane >> 5); float w = W[(size_t)(k0 + kk) * N + n0 + (lane & 31)]; if (gk) w *= gk[k0 + kk]; scr[kk * 33 + (lane & 31)] = w; }
    asm volatile("s_waitcnt lgkmcnt(0)" ::: "memory");
    const int c = lane & 7; const int dr0 = dst_row(mode, n0);
#pragma unroll
    for (int j = 0; j < 4; ++j) { const int n = (lane >> 3) + 8 * j; const LAS float* s = scr + (8 * c) * 33 + n;
        u32x4 o; o.x = pk2(s[0 * 33], s[1 * 33]); o.y = pk2(s[2 * 33], s[3 * 33]); o.z = pk2(s[4 * 33], s[5 * 33]); o.w = pk2(s[6 * 33], s[7 * 33]);
        *(u32x4*)(WT + (size_t)(dr0 + n) * K + k0 + 8 * c) = o; }
    asm volatile("s_waitcnt lgkmcnt(0)" ::: "memory");
}

struct Args { const float* in[23]; float* out; unsigned char* ws; int ph_lo, ph_hi; };

__device__ __forceinline__ void prologue_phase(const Args& args, LAS unsigned char* lds, int lane, int wave, int G, int bx) {
    unsigned char* ws = args.ws;
    LAS float* scr = (LAS float*)(lds + wave * 16384);
    const int gw = bx * 8 + wave, NGW = G * 8;
    constexpr int I_G = (D / 64) * (FF / 32), I_D = (FF / 64) * (D / 32), I_IN = (D / 64) * (DIN / 32), I_OUT = (D / 64) * (D / 32);
    constexpr int I_LAYER = 4 * I_G + 2 * I_D + I_IN + I_OUT;
    for (int it = gw; it < NLAYER * I_LAYER; it += NGW) {
        const int l = it / I_LAYER; int r = it % I_LAYER;
        unsigned char* wl = ws + WS_W + (size_t)l * W_LAYER;
        const size_t oG = (size_t)l * D * FF, oD = (size_t)l * FF * D;
        if (r < I_G) { p0_transpose_item(args.in[2] + oG, D, FF, (bf16_t*)(wl + W_GU1), 1, args.in[1] + l * D, scr, r, lane); continue; } r -= I_G;
        if (r < I_G) { p0_transpose_item(args.in[3] + oG, D, FF, (bf16_t*)(wl + W_GU1), 2, args.in[1] + l * D, scr, r, lane); continue; } r -= I_G;
        if (r < I_D) { p0_transpose_item(args.in[4] + oD, FF, D, (bf16_t*)(wl + W_D1), 0, nullptr, scr, r, lane); continue; } r -= I_D;
        if (r < I_IN) { p0_transpose_item(args.in[6] + (size_t)l * D * DIN, D, DIN, (bf16_t*)(wl + W_IN), 3, args.in[5] + l * D, scr, r, lane); continue; } r -= I_IN;
        if (r < I_OUT) { p0_transpose_item(args.in[17] + (size_t)l * D * D, D, D, (bf16_t*)(wl + W_OUT), 0, nullptr, scr, r, lane); continue; } r -= I_OUT;
        if (r < I_G) { p0_transpose_item(args.in[19] + oG, D, FF, (bf16_t*)(wl + W_GU2), 1, args.in[18] + l * D, scr, r, lane); continue; } r -= I_G;
        if (r < I_G) { p0_transpose_item(args.in[20] + oG, D, FF, (bf16_t*)(wl + W_GU2), 2, args.in[18] + l * D, scr, r, lane); continue; } r -= I_G;
        p0_transpose_item(args.in[21] + oD, FF, D, (bf16_t*)(wl + W_D2), 0, nullptr, scr, r, lane);
    }
    const float* x = args.in[0]; bf16_t* xb = (bf16_t*)(ws + WS_XB); float* ssq = (float*)(ws + WS_SSQ);
    for (int m = gw; m < M; m += NGW) {
        const f32x4* xr = (const f32x4*)(x + (size_t)m * D) + lane;
        f32x4 v[4]; float s = 0.f;
#pragma unroll
        for (int j = 0; j < 4; ++j) { v[j] = xr[64 * j]; s += (v[j][0] * v[j][0] + v[j][1] * v[j][1]) + (v[j][2] * v[j][2] + v[j][3] * v[j][3]); }
        s = wave_sum(s);
        u32x2* o8 = (u32x2*)(xb + (size_t)m * D) + lane;
#pragma unroll
        for (int j = 0; j < 4; ++j) { u32x2 o; o.x = pk2(v[j][0], v[j][1]); o.y = pk2(v[j][2], v[j][3]); o8[64 * j] = o; }
        if (lane < 16) ssq[(size_t)m * 16 + lane] = (lane == 0) ? s : 0.f;
    }
}

__device__ __forceinline__ void final_phase(const Args& args, int lane, int wave, int G, int bx) {
    const float* ssq = (const float*)(args.ws + WS_SSQ); const float* g = args.in[22]; float* out = args.out;
    const int gw = bx * 8 + wave, NGW = G * 8;
    f32x4 gv[4];
#pragma unroll
    for (int j = 0; j < 4; ++j) gv[j] = ((const f32x4*)g)[lane + 64 * j];
    for (int m = gw; m < M; m += NGW) {
        float s = (lane < 16) ? ssq[(size_t)m * 16 + lane] : 0.f;
        s = wave_sum(s);
        const float rs = 1.0f / sqrtf(s * (1.0f / D) + EPS);
        f32x4* xr = (f32x4*)(out + (size_t)m * D) + lane;
#pragma unroll
        for (int j = 0; j < 4; ++j) { f32x4 v = xr[64 * j]; v = v * rs * gv[j]; xr[64 * j] = v; }
    }
}

__device__ __forceinline__ void mixer_phase(LAS unsigned char* lds, const bf16_t* Z, bf16_t* Y,
        const float* sgu_g, const float* sgu_b, const float* wsp, const float* bsp,
        const float* cw, const float* cbias, const float* cln_g, const float* cln_b,
        const float* pw, const float* ps, int tid, int lane, int wave, int G, int bx) {
    LAS bf16_t* VT = (LAS bf16_t*)(lds + L_VT);
    LAS float* CW = (LAS float*)(lds + L_CW);
    LAS bf16_t* PW = (LAS bf16_t*)(lds + L_PW);
    const int fr = lane & 15, kq = lane >> 4;
    for (int unit = bx; unit < 256; unit += G) {
        const int chunk = unit >> 1, half = unit & 1;
        const int cb0 = chunk * 128;
        __syncthreads();
        for (int i = tid; i < 32 * 384 / 4; i += 512) ((LAS f32x4*)CW)[i] = (i < 31 * 384 / 4) ? ((const f32x4*)cw)[i] : (f32x4){0.f, 0.f, 0.f, 0.f};
        for (int i = tid; i < 4 * 64 * 64; i += 512) { const int g = i >> 12, c = (i >> 6) & 63, d = i & 63; PW[(g * 64 + d) * PW_LD + c] = (bf16_t)f2bf(pw[i]); }
        {
            float gg[6], bb[6];
#pragma unroll
            for (int k = 0; k < 6; ++k) { gg[k] = sgu_g[6 * lane + k]; bb[k] = sgu_b[6 * lane + k]; }
#pragma unroll 4
            for (int qi = 0; qi < 16; ++qi) {
                const int q = 16 * wave + qi;
                float v[6]; ld6(Z + (size_t)(cb0 + q) * ZLD + 384 + 6 * lane, v);
                float s = ((v[0] + v[1]) + (v[2] + v[3])) + (v[4] + v[5]);
                const float mean = wave_sum(s) * (1.0f / 384.0f);
                float s2 = 0.f;
#pragma unroll
                for (int k = 0; k < 6; ++k) { v[k] -= mean; s2 += v[k] * v[k]; }
                const float rstd = 1.0f / sqrtf(wave_sum(s2) * (1.0f / 384.0f) + EPS);
                if ((lane >> 5) == half) {
#pragma unroll
                    for (int k = 0; k < 6; ++k) VT[(6 * (lane & 31) + k) * VT_LD + q] = (bf16_t)f2bf(v[k] * rstd * gg[k] + bb[k]);
                }
            }
        }
        __syncthreads();
        {
            const int p = 16 * wave + fr;
            const int nks = (wave >> 1) + 1;
#pragma unroll 1
            for (int hl = 0; hl < 3; ++hl) {
                const int h = 3 * half + hl;
                f32x4 accd[4];
#pragma unroll
                for (int ct = 0; ct < 4; ++ct) accd[ct] = (f32x4){0.f, 0.f, 0.f, 0.f};
                for (int ks = 0; ks < nks; ++ks) {
                    const int q0 = 32 * ks + 8 * kq;
                    const float* wp = wsp + ((size_t)h * 128 + p) * 128 + q0;
                    const f32x4 w0 = *(const f32x4*)wp, w1 = *(const f32x4*)(wp + 4);
                    u32x4 bw;
                    bw.x = pk2(q0 + 0 <= p ? w0[0] : 0.f, q0 + 1 <= p ? w0[1] : 0.f); bw.y = pk2(q0 + 2 <= p ? w0[2] : 0.f, q0 + 3 <= p ? w0[3] : 0.f);
                    bw.z = pk2(q0 + 4 <= p ? w1[0] : 0.f, q0 + 5 <= p ? w1[1] : 0.f); bw.w = pk2(q0 + 6 <= p ? w1[2] : 0.f, q0 + 7 <= p ? w1[3] : 0.f);
                    const bf16x8 bfrag = __builtin_bit_cast(bf16x8, bw);
#pragma unroll
                    for (int ct = 0; ct < 4; ++ct) {
                        const bf16x8 afrag = *(const LAS bf16x8*)(VT + (hl * 64 + 16 * ct + fr) * VT_LD + q0);
                        accd[ct] = __builtin_amdgcn_mfma_f32_16x16x32_bf16(afrag, bfrag, accd[ct], 0, 0, 0);
                    }
                }
                const float bs = bsp[h * 128 + p];
                const size_t trow = (size_t)(cb0 + p);
#pragma unroll
                for (int ct = 0; ct < 4; ++ct) {
                    const int c0 = h * 64 + 16 * ct + 4 * kq;
                    const u32x2 uu = *(const u32x2*)(Z + trow * ZLD + c0);
                    u32x2 o;
                    o.x = pk2(bf_lo(uu.x) * (accd[ct][0] + bs), bf_hi(uu.x) * (accd[ct][1] + bs));
                    o.y = pk2(bf_lo(uu.y) * (accd[ct][2] + bs), bf_hi(uu.y) * (accd[ct][3] + bs));
                    *(u32x2*)(Y + trow * D + c0) = o;
                }
            }
        }
        {
            float cbv[6], lg[6], lb[6];
#pragma unroll
            for (int k = 0; k < 6; ++k) { cbv[k] = cbias[6 * lane + k]; lg[k] = cln_g[6 * lane + k]; lb[k] = cln_b[6 * lane + k]; }
#pragma unroll 1
            for (int ti = 0; ti < 8; ++ti) {
                const int t = cb0 + 64 * half + 8 * wave + ti, tpos = t & (SEQ - 1);
                float a[6];
#pragma unroll
                for (int k = 0; k < 6; ++k) a[k] = cbv[k];
#pragma unroll 1
                for (int jb = 0; jb < 32; jb += 8) {
#pragma unroll
                    for (int jj = 0; jj < 8; ++jj) {
                        const int j = jb + jj; const int tt = tpos - 30 + j;
                        const bool valid = (tt >= 0) && (j < 31);
                        const int row = valid ? (t - 30 + j) : t;
                        float x[6]; ld6(Z + (size_t)row * ZLD + 768 + 6 * lane, x);
                        const LAS float* wr_ = CW + j * 384 + 6 * lane;
                        const float sc = valid ? 1.0f : 0.0f;
#pragma unroll
                        for (int k = 0; k < 6; ++k) a[k] += (wr_[k] * sc) * x[k];
                    }
                }
                float s = ((a[0] + a[1]) + (a[2] + a[3])) + (a[4] + a[5]);
                const float mean = wave_sum(s) * (1.0f / 384.0f);
                float s2 = 0.f;
#pragma unroll
                for (int k = 0; k < 6; ++k) { a[k] -= mean; s2 += a[k] * a[k]; }
                const float rstd = 1.0f / sqrtf(wave_sum(s2) * (1.0f / 384.0f) + EPS);
                float y[6];
#pragma unroll
                for (int k = 0; k < 6; ++k) { const float v = a[k] * rstd * lg[k] + lb[k]; y[k] = v / (1.0f + __expf(-v)); }
                unsigned* yo = (unsigned*)(Y + (size_t)t * D + 384 + 6 * lane);
                yo[0] = pk2(y[0], y[1]); yo[1] = pk2(y[2], y[3]); yo[2] = pk2(y[4], y[5]);
            }
        }
        {
            const int t = cb0 + 64 * half + 16 * (wave & 3) + fr, tpos = t & (SEQ - 1);
#pragma unroll 1
            for (int gi = 0; gi < 2; ++gi) {
                const int g = 2 * (wave >> 2) + gi, win = 2 << g;
                const float inv = 1.0f / (float)((tpos + 1 < win) ? (tpos + 1) : win);
                f32x4 accd[4];
#pragma unroll
                for (int dt = 0; dt < 4; ++dt) accd[dt] = (f32x4){0.f, 0.f, 0.f, 0.f};
#pragma unroll 1
                for (int ks = 0; ks < 2; ++ks) {
                    const int c0 = g * 64 + 32 * ks + 8 * kq;
                    const bf16_t* pp = Z + (size_t)t * ZLD + 1152 + c0;
                    const u32x4 cur = *(const u32x4*)pp;
                    float s[8] = {bf_lo(cur.x), bf_hi(cur.x), bf_lo(cur.y), bf_hi(cur.y), bf_lo(cur.z), bf_hi(cur.z), bf_lo(cur.w), bf_hi(cur.w)};
                    for (int i = 1; i < win; ++i) {
                        const bool valid = (i <= tpos);
                        const u32x4 r = *(const u32x4*)(pp - (valid ? (size_t)i * ZLD : 0));
                        const float sc = valid ? 1.0f : 0.0f;
                        s[0] += sc * bf_lo(r.x); s[1] += sc * bf_hi(r.x); s[2] += sc * bf_lo(r.y); s[3] += sc * bf_hi(r.y);
                        s[4] += sc * bf_lo(r.z); s[5] += sc * bf_hi(r.z); s[6] += sc * bf_lo(r.w); s[7] += sc * bf_hi(r.w);
                    }
                    u32x4 bw;
                    bw.x = pk2(s[0] * inv - bf_lo(cur.x), s[1] * inv - bf_hi(cur.x)); bw.y = pk2(s[2] * inv - bf_lo(cur.y), s[3] * inv - bf_hi(cur.y));
                    bw.z = pk2(s[4] * inv - bf_lo(cur.z), s[5] * inv - bf_hi(cur.z)); bw.w = pk2(s[6] * inv - bf_lo(cur.w), s[7] * inv - bf_hi(cur.w));
                    const bf16x8 bfrag = __builtin_bit_cast(bf16x8, bw);
#pragma unroll
                    for (int dt = 0; dt < 4; ++dt) {
                        const bf16x8 afrag = *(const LAS bf16x8*)(PW + (g * 64 + 16 * dt + fr) * PW_LD + 32 * ks + 8 * kq);
                        accd[dt] = __builtin_amdgcn_mfma_f32_16x16x32_bf16(afrag, bfrag, accd[dt], 0, 0, 0);
                    }
                }
#pragma unroll
                for (int dt = 0; dt < 4; ++dt) {
                    const int d0 = g * 64 + 16 * dt + 4 * kq;
                    const f32x4 sc = *(const f32x4*)(ps + d0);
                    u32x2 o; o.x = pk2(accd[dt][0] * sc[0], accd[dt][1] * sc[1]); o.y = pk2(accd[dt][2] * sc[2], accd[dt][3] * sc[3]);
                    *(u32x2*)(Y + (size_t)t * D + 768 + d0) = o;
                }
            }
        }
    }
}

__global__ void __launch_bounds__(512, 2) mk_fwd(Args args) {
    extern __shared__ __attribute__((aligned(16))) unsigned char lds_raw[];
    LAS unsigned char* lds = (LAS unsigned char*)lds_raw;
    const int tid = threadIdx.x, lane = tid & 63, wave = __builtin_amdgcn_readfirstlane(tid >> 6);
    const int G = gridDim.x, bx = blockIdx.x;
    if (args.ph_lo == 0) { prologue_phase(args, lds, lane, wave, G, bx); if (args.ph_hi > 1) cg::this_grid().sync(); }
    const int plo = args.ph_lo < 1 ? 1 : args.ph_lo, phi = args.ph_hi > NPHASE - 1 ? NPHASE - 1 : args.ph_hi;
#pragma unroll 1
    for (int ph = plo; ph < phi; ++ph) {
        int tid_ = threadIdx.x; asm volatile("" : "+v"(tid_));
        const int lane_ = tid_ & 63, wave_ = __builtin_amdgcn_readfirstlane(tid_ >> 6);
        unsigned char* wsp_ = args.ws; asm volatile("" : "+s"(wsp_));
        bf16_t* XB = (bf16_t*)(wsp_ + WS_XB); bf16_t* HB = (bf16_t*)(wsp_ + WS_H); bf16_t* ZB = (bf16_t*)(wsp_ + WS_Z); bf16_t* YB = (bf16_t*)(wsp_ + WS_Y);
        float* SSQ = (float*)(wsp_ + WS_SSQ);
        const int l = (ph - 1) / 7, s = (ph - 1) % 7;
        unsigned char* wl = wsp_ + WS_W + (size_t)l * W_LAYER;
        if (s == 0 || s == 5) {
            pg8::Gemm g{XB, (const bf16_t*)(wl + (s == 0 ? W_GU1 : W_GU2)), M, 2 * FF, D};
            pg8::StaticOrder S; S.init(M, 2 * FF, G, bx);
            pg8::EpiSwiGLU E{HB, FF, SSQ};
            pg8::gemm_phase<pg8::EpiSwiGLU, pg8::StaticOrder, true, true>(lds, g, S, E);
        } else if (s == 1 || s == 6 || s == 4) {
            pg8::Gemm g{s == 4 ? YB : HB, (const bf16_t*)(wl + (s == 1 ? W_D1 : (s == 6 ? W_D2 : W_OUT))), M, D, s == 4 ? D : FF};
            pg8::StaticOrder S; S.init(M, D, G, bx);
            pg8::EpiRes E{(l == 0 && s == 1) ? args.in[0] : args.out, args.out, XB, SSQ, s == 4 ? 1.0f : 0.5f};
            pg8::gemm_phase<pg8::EpiRes, pg8::StaticOrder, true, true>(lds, g, S, E);
        } else if (s == 2) {
            pg8::Gemm g{XB, (const bf16_t*)(wl + W_IN), M, DIN, D};
            pg8::StaticOrder S; S.init(M, DIN, G, bx);
            pg8::EpiWin E{ZB, ZLD, SSQ};
            pg8::gemm_phase<pg8::EpiWin, pg8::StaticOrder, true, true>(lds, g, S, E);
        } else {
            mixer_phase(lds, ZB, YB, args.in[7] + l * 384, args.in[8] + l * 384, args.in[9] + (size_t)l * 6 * 128 * 128, args.in[10] + l * 6 * 128,
                        args.in[11] + (size_t)l * 31 * 384, args.in[12] + l * 384, args.in[13] + l * 384, args.in[14] + l * 384,
                        args.in[15] + (size_t)l * 4 * 64 * 64, args.in[16] + l * 256, tid_, lane_, wave_, G, bx);
        }
        if (ph + 1 < args.ph_hi) { cg::this_grid().sync(); }
    }
    if (args.ph_hi == NPHASE) final_phase(args, lane, wave, G, bx);
}

extern "C" void kernel_launch(void* const* d_in, const int* in_sizes, int n_in, void* d_out, int out_size, void* d_ws, size_t ws_size, hipStream_t stream) {
    static int grid = 0;
    if (grid == 0) {
        int dev = 0, cus = 0, per_cu = 0;
        hipGetDevice(&dev);
        hipDeviceGetAttribute(&cus, hipDeviceAttributeMultiprocessorCount, dev);
        if (hipFuncSetAttribute((const void*)mk_fwd, hipFuncAttributeMaxDynamicSharedMemorySize, LDS_BYTES) != hipSuccess) fprintf(stderr, "kernel_launch: hipFuncSetAttribute failed\n");
        if (hipOccupancyMaxActiveBlocksPerMultiprocessor(&per_cu, (const void*)mk_fwd, 512, LDS_BYTES) != hipSuccess || per_cu < 1) { fprintf(stderr, "kernel_launch: occupancy query says %d\n", per_cu); per_cu = 1; }
        (void)hipGetLastError();
        grid = cus * 1;
        if (grid <= 0) grid = 256;
    }
    Args a{};
    for (int i = 0; i < 23; ++i) a.in[i] = (const float*)d_in[i];
    a.out = (float*)d_out; a.ws = (unsigned char*)d_ws;
#if MK_PER_PHASE
    for (int ph = 0; ph < NPHASE; ++ph) { a.ph_lo = ph; a.ph_hi = ph + 1; hipLaunchKernelGGL(mk_fwd, dim3(grid), dim3(512), LDS_BYTES, stream, a); }
#else
    a.ph_lo = 0; a.ph_hi = NPHASE;
    void* kargs[] = {&a};
    const hipError_t e = hipLaunchCooperativeKernel((const void*)mk_fwd, dim3(grid), dim3(512), kargs, LDS_BYTES, stream);
    if (e != hipSuccess) fprintf(stderr, "kernel_launch: cooperative launch failed: %s (grid %d)\n", hipGetErrorString(e), grid);
#endif
}
```

```cpp
#include <hip/hip_runtime.h>
#include <hip/hip_cooperative_groups.h>
#include <cstdio>
#include <cstdint>
namespace cg = cooperative_groups;
namespace pg8 {
#define PG8_LAS __attribute__((address_space(3)))
typedef unsigned short bf16_t;
typedef short bf16x8 __attribute__((ext_vector_type(8)));
typedef float f32x4 __attribute__((ext_vector_type(4)));
typedef unsigned u32x4 __attribute__((ext_vector_type(4)));
constexpr int BM = 256, BK = 64, HALF = 128, HTB = HALF * BK * 2  , STAGE_BYTES = 8 * HTB, NXCD = 8, WGM = 8;

__host__ __device__ __forceinline__ int lds_byte(int r, int c) { const int st = (r >> 4) * 2 + (c >> 5), rr = r & 15, cc = c & 31, ob = rr * 64 + cc * 2; return st * 1024 + (ob ^ (((ob >> 9) & 1) << 5)); }
__host__ __device__ __forceinline__ void stage_rc(int b, int& R, int& C) { const int st = b / 1024, sb = b % 1024, swz = sb ^ (((sb >> 9) & 1) << 5); R = (st >> 1) * 16 + swz / 64; C = (st & 1) * 32 + (swz % 64) / 2; }
__host__ __device__ __forceinline__ int perm32(int rho) { const int n = rho >> 4, i = rho & 15; return 8 * (i >> 2) + 4 * n + (i & 3); }

struct Unit { int pm, pn; };
struct Gemm { const bf16_t* A; const bf16_t* Bt; int M, N, K; };

struct StaticOrder {
    int nM, nN, nwg, G, c;
    __host__ __device__ void init(int M, int N, int G_, int c_) { nM = M / BM; nN = N / BM; nwg = nM * nN; G = G_; c = c_; }
    __host__ __device__ bool next(int i, Unit& u) const {
        const long L = (long)i * G + c; if (L >= nwg) return false;
        int wgid = (int)L; { const int q = nwg / NXCD, r = nwg % NXCD, xcd = wgid % NXCD, off = wgid / NXCD; wgid = (xcd < r ? xcd * (q + 1) : r * (q + 1) + (xcd - r) * q) + off; }
        const int nig = WGM * nN, gid = wgid / nig, fm = gid * WGM, gsz = (nM - fm) < WGM ? (nM - fm) : WGM;
        u.pm = fm + ((wgid % nig) % gsz); u.pn = (wgid % nig) / gsz; return true;
    }
    __device__ __forceinline__ void a_ready(const Unit&) const {}
    __device__ __forceinline__ void done(const Unit&) const {}
};

__device__ __forceinline__ unsigned cvt_pk_bf16(float lo, float hi) { unsigned r; asm volatile("v_cvt_pk_bf16_f32 %0, %1, %2" : "=v"(r) : "v"(lo), "v"(hi)); return r; }
typedef float f32x2 __attribute__((ext_vector_type(2)));
__device__ __forceinline__ f32x2 gelu_pk(f32x2 v) {
    const f32x2 av = __builtin_elementwise_abs(v), d = av * 0.2316418882f + 1.0f;
    f32x2 t; t.x = __builtin_amdgcn_rcpf(d.x); t.y = __builtin_amdgcn_rcpf(d.y);
    f32x2 q = t * 0.5307027145f + (-0.7265760135f); q = q * t + 0.7107068705f; q = q * t + (-0.142248368f); q = q * t + 0.127414796f; q = q * t;
    const f32x2 s = (v * v) * (-0.72134752044f);
    f32x2 e; e.x = __builtin_amdgcn_exp2f(s.x); e.y = __builtin_amdgcn_exp2f(s.y);
    const f32x2 m = v * (q * e), r = v - m;
    f32x2 o; o.x = v.x < 0.f ? m.x : r.x; o.y = v.y < 0.f ? m.y : r.y; return o;
}

__device__ __forceinline__ float row_rstd(const float* ssq, int row, int fq) {
    const f32x4 p = *(const f32x4*)(ssq + (size_t)row * 16 + 4 * fq);
    float s = (p[0] + p[1]) + (p[2] + p[3]);
    s += __shfl_xor(s, 16); s += __shfl_xor(s, 32);
    return __builtin_amdgcn_rsqf(s * (1.0f / 1024.0f) + 1e-6f);
}
__device__ __forceinline__ float silu_f(float g) { return g * __builtin_amdgcn_rcpf(1.0f + __builtin_amdgcn_exp2f(g * -1.44269504089f)); }
__device__ __forceinline__ float sigm_f(float g) { return __builtin_amdgcn_rcpf(1.0f + __builtin_amdgcn_exp2f(g * -1.44269504089f)); }

struct EpiSwiGLU {
    static constexpr bool PERM = true, AFTER_DRAIN = false;
    bf16_t* O; int ldo; const float* ssq;
    __device__ __forceinline__ void operator()(const f32x4 (&acc)[2][2][4][2], const Unit& u, int wr, int wc, int fr, int fq) const {
        const int row0 = u.pm * BM + wr * 64 + fr, col0 = u.pn * HALF + wc * 32 + 8 * fq;
#pragma unroll
        for (int ai = 0; ai < 2; ++ai)
#pragma unroll
            for (int m = 0; m < 4; ++m) {
                const int row = row0 + ai * HALF + m * 16;
                const float rs = row_rstd(ssq, row, fq);
                const f32x4 g0 = acc[ai][0][m][0] * rs, g1 = acc[ai][0][m][1] * rs, u0 = acc[ai][1][m][0] * rs, u1 = acc[ai][1][m][1] * rs;
                u32x4 w;
                w.x = cvt_pk_bf16(silu_f(g0[0]) * u0[0], silu_f(g0[1]) * u0[1]); w.y = cvt_pk_bf16(silu_f(g0[2]) * u0[2], silu_f(g0[3]) * u0[3]);
                w.z = cvt_pk_bf16(silu_f(g1[0]) * u1[0], silu_f(g1[1]) * u1[1]); w.w = cvt_pk_bf16(silu_f(g1[2]) * u1[2], silu_f(g1[3]) * u1[3]);
                *(u32x4*)(O + (size_t)row * ldo + col0) = w;
            }
    }
};

struct EpiRes {
    static constexpr bool PERM = true, AFTER_DRAIN = false;
    const float* base; float* out; bf16_t* xb; float* ssq; float w;
    __device__ __forceinline__ void operator()(const f32x4 (&acc)[2][2][4][2], const Unit& u, int wr, int wc, int fr, int fq) const {
        const int row0 = u.pm * BM + wr * 64 + fr, col0 = u.pn * BM + wc * 32 + 8 * fq;
#pragma unroll
        for (int ai = 0; ai < 2; ++ai)
#pragma unroll
            for (int m = 0; m < 4; ++m) {
                const int row = row0 + ai * HALF + m * 16; float q = 0.f;
#pragma unroll
                for (int bj = 0; bj < 2; ++bj) {
                    const size_t off = (size_t)row * 1024 + col0 + bj * HALF;
                    const f32x4 b0 = *(const f32x4*)(base + off), b1 = *(const f32x4*)(base + off + 4);
                    const f32x4 v0 = b0 + acc[ai][bj][m][0] * w, v1 = b1 + acc[ai][bj][m][1] * w;
                    *(f32x4*)(out + off) = v0; *(f32x4*)(out + off + 4) = v1;
                    u32x4 pk; pk.x = cvt_pk_bf16(v0[0], v0[1]); pk.y = cvt_pk_bf16(v0[2], v0[3]); pk.z = cvt_pk_bf16(v1[0], v1[1]); pk.w = cvt_pk_bf16(v1[2], v1[3]);
                    *(u32x4*)(xb + off) = pk;
                    q += (v0[0] * v0[0] + v0[1] * v0[1]) + (v0[2] * v0[2] + v0[3] * v0[3]) + (v1[0] * v1[0] + v1[1] * v1[1]) + (v1[2] * v1[2] + v1[3] * v1[3]);
                }
                q += __shfl_xor(q, 16); q += __shfl_xor(q, 32);
                if (fq == 0) ssq[(size_t)row * 16 + u.pn * 4 + wc] = q;
                if (m & 1) asm volatile("" ::: "memory");
            }
    }
};

struct EpiWin {
    static constexpr bool PERM = true, AFTER_DRAIN = false;
    bf16_t* Z; int ldz; const float* ssq;
    __device__ __forceinline__ void operator()(const f32x4 (&acc)[2][2][4][2], const Unit& u, int wr, int wc, int fr, int fq) const {
        const int row0 = u.pm * BM + wr * 64 + fr, cw = wc * 32 + 8 * fq;
#pragma unroll
        for (int ai = 0; ai < 2; ++ai)
#pragma unroll
            for (int m = 0; m < 4; ++m) {
                const int row = row0 + ai * HALF + m * 16;
                const float rs = row_rstd(ssq, row, fq);
                bf16_t* zr = Z + (size_t)row * ldz;
                if (u.pn >= 3 && u.pn < 6) {
                    const f32x4 a0 = acc[ai][0][m][0] * rs, a1 = acc[ai][0][m][1] * rs, g0 = acc[ai][1][m][0] * rs, g1 = acc[ai][1][m][1] * rs;
                    u32x4 pk;
                    pk.x = cvt_pk_bf16(a0[0] * sigm_f(g0[0]), a0[1] * sigm_f(g0[1])); pk.y = cvt_pk_bf16(a0[2] * sigm_f(g0[2]), a0[3] * sigm_f(g0[3]));
                    pk.z = cvt_pk_bf16(a1[0] * sigm_f(g1[0]), a1[1] * sigm_f(g1[1])); pk.w = cvt_pk_bf16(a1[2] * sigm_f(g1[2]), a1[3] * sigm_f(g1[3]));
                    *(u32x4*)(zr + 768 + 128 * (u.pn - 3) + cw) = pk;
                } else {
                    const int cbase = (u.pn < 3) ? 256 * u.pn : 1152;
#pragma unroll
                    for (int bj = 0; bj < 2; ++bj) {
                        f32x4 v0 = acc[ai][bj][m][0] * rs, v1 = acc[ai][bj][m][1] * rs;
                        if (u.pn < 3) { const f32x2 a = gelu_pk((f32x2){v0[0], v0[1]}), b = gelu_pk((f32x2){v0[2], v0[3]}), c = gelu_pk((f32x2){v1[0], v1[1]}), d = gelu_pk((f32x2){v1[2], v1[3]});
                            v0 = (f32x4){a.x, a.y, b.x, b.y}; v1 = (f32x4){c.x, c.y, d.x, d.y}; }
                        u32x4 pk; pk.x = cvt_pk_bf16(v0[0], v0[1]); pk.y = cvt_pk_bf16(v0[2], v0[3]); pk.z = cvt_pk_bf16(v1[0], v1[1]); pk.w = cvt_pk_bf16(v1[2], v1[3]);
                        *(u32x4*)(zr + cbase + bj * HALF + cw) = pk;
                    }
                }
            }
    }
};

template <class Epi, class Sched, bool ALIGN_EPI = false, bool SP2 = false>
__device__ __forceinline__ void gemm_phase(PG8_LAS unsigned char* lds, const Gemm g, const Sched& S, const Epi& E) {
    int tid = threadIdx.x; asm volatile("" : "+v"(tid));
    const int wid = __builtin_amdgcn_readfirstlane(tid >> 6), lane = tid & 63, wr = wid >> 2, wc = wid & 3, fr = lane & 15, fq = lane >> 4;
    const int K = g.K, nt = K / BK;
    unsigned voffA[2], voffB[2];
#pragma unroll
    for (int i = 0; i < 2; ++i) { int R, C; stage_rc(tid * 16 + i * 8192, R, C); const int Rb = Epi::PERM ? ((R & ~31) + perm32(R & 31)) : R;
        voffA[i] = (unsigned)(R * K + C) * 2u; voffB[i] = (unsigned)(Rb * K + C) * 2u; }
    const size_t kstep = (size_t)(BK * 2);
    const size_t hstep = (size_t)HALF * K * 2;
    const size_t tstep = 2 * hstep;
    const unsigned ldsw = (unsigned)wid * 1024u;
    const int aoff = lds_byte(wr * 64 + fr, fq * 8), boff = lds_byte(wc * 32 + fr, fq * 8);
#define PG8_SA(b, h) (((b) * 2 + (h)) * HTB)
#define PG8_SB(b, h) ((4 + (b) * 2 + (h)) * HTB)
#define PG8_STAGE(bufoff, gbase, voff) do { _Pragma("unroll") for (int _i = 0; _i < 2; ++_i) \
        __builtin_amdgcn_global_load_lds((const unsigned*)((const char*)(gbase) + (voff)[_i]), (PG8_LAS unsigned*)(lds + (bufoff) + ldsw + _i * 8192), 16, 0, 0); } while (0)
#define PG8_LDA(dst, b, h) do { _Pragma("unroll") for (int m = 0; m < 4; ++m) _Pragma("unroll") for (int k = 0; k < 2; ++k) dst[m][k] = *(const PG8_LAS bf16x8*)(lds + PG8_SA(b, h) + aoff + m * 2048 + k * 1024); } while (0)
#define PG8_LDB(dst, b, h) do { _Pragma("unroll") for (int n = 0; n < 2; ++n) _Pragma("unroll") for (int k = 0; k < 2; ++k) dst[n][k] = *(const PG8_LAS bf16x8*)(lds + PG8_SB(b, h) + boff + n * 2048 + k * 1024); } while (0)
#define PG8_MMA(ai, bj, At, Bt) do { __builtin_amdgcn_s_setprio(1); _Pragma("unroll") for (int m = 0; m < 4; ++m) _Pragma("unroll") for (int n = 0; n < 2; ++n) _Pragma("unroll") for (int k = 0; k < 2; ++k) \
        acc[ai][bj][m][n] = __builtin_amdgcn_mfma_f32_16x16x32_bf16(Bt[n][k], At[m][k], acc[ai][bj][m][n], 0, 0, 0); __builtin_amdgcn_s_setprio(0); } while (0)
#define PG8_WAIT_V(n) asm volatile("s_waitcnt vmcnt(" #n ")" ::: "memory")
#define PG8_WAIT_L(n) asm volatile("s_waitcnt lgkmcnt(" #n ")" ::: "memory")
#define PG8_BAR __builtin_amdgcn_s_barrier()
#define PG8_SCHED __builtin_amdgcn_sched_barrier(0)
    Unit cur, nxt; int ui = 0;
    if (!S.next(0, cur)) return;
    f32x4 acc[2][2][4][2];
#pragma unroll
    for (int a = 0; a < 2; ++a)
#pragma unroll
        for (int b = 0; b < 2; ++b)
#pragma unroll
            for (int m = 0; m < 4; ++m)
#pragma unroll
                for (int n = 0; n < 2; ++n) acc[a][b][m][n] = (f32x4){0.f, 0.f, 0.f, 0.f};
    bf16x8 At[4][2], B0[2][2], B1[2][2];
    const char* cA = (const char*)g.A + (size_t)cur.pm * tstep; const char* cB = (const char*)g.Bt + (size_t)cur.pn * tstep;
    S.a_ready(cur);
    if constexpr (SP2) {
        PG8_STAGE(PG8_SB(0, 0), cB, voffB); PG8_STAGE(PG8_SB(0, 1), cB + hstep, voffB); PG8_STAGE(PG8_SA(0, 0), cA, voffA); PG8_STAGE(PG8_SA(0, 1), cA + hstep, voffA);
        if (wr == 1) PG8_BAR;
        PG8_WAIT_V(2); PG8_BAR;
        PG8_STAGE(PG8_SB(1, 0), cB + kstep, voffB); PG8_STAGE(PG8_SA(1, 0), cA + kstep, voffA); PG8_STAGE(PG8_SB(1, 1), cB + hstep + kstep, voffB);
        PG8_WAIT_V(6); PG8_BAR;
    } else {
        PG8_STAGE(PG8_SB(0, 0), cB, voffB); PG8_STAGE(PG8_SA(0, 0), cA, voffA); PG8_STAGE(PG8_SB(0, 1), cB + hstep, voffB); PG8_STAGE(PG8_SA(0, 1), cA + hstep, voffA);
        if (wr == 1) PG8_BAR;
        PG8_WAIT_V(4); PG8_BAR;
        PG8_STAGE(PG8_SB(1, 0), cB + kstep, voffB); PG8_STAGE(PG8_SA(1, 0), cA + kstep, voffA); PG8_STAGE(PG8_SB(1, 1), cB + hstep + kstep, voffB);
        PG8_WAIT_V(6); PG8_BAR;
    }
    for (;;) {
        const bool has_next = S.next(ui + 1, nxt);
        const char* nA = has_next ? (const char*)g.A + (size_t)nxt.pm * tstep : cA; const char* nB = has_next ? (const char*)g.Bt + (size_t)nxt.pn * tstep : cB;
        for (int t = 0; t < nt; t += 2) {
            const bool last = (t == nt - 2);
            const char* a1 = cA + (size_t)(t + 1) * kstep;
            const char* a2 = last ? nA : cA + (size_t)(t + 2) * kstep; const char* b2 = last ? nB : cB + (size_t)(t + 2) * kstep;
            const char* a3 = a2 + kstep; const char* b3 = b2 + kstep;
            if (last && has_next) S.a_ready(nxt);
            if constexpr (SP2) {
            PG8_LDB(B0, 0, 0); PG8_LDB(B1, 0, 1); PG8_SCHED; PG8_LDA(At, 0, 0); PG8_STAGE(PG8_SA(1, 1), a1 + hstep, voffA);
            PG8_WAIT_V(8); PG8_WAIT_L(0); PG8_BAR; PG8_MMA(0, 0, At, B0); PG8_MMA(0, 1, At, B1); PG8_BAR; PG8_SCHED;
            PG8_LDA(At, 0, 1); PG8_STAGE(PG8_SB(0, 0), b2, voffB); PG8_STAGE(PG8_SB(0, 1), b2 + hstep, voffB); PG8_STAGE(PG8_SA(0, 0), a2, voffA);
            PG8_WAIT_V(8); PG8_WAIT_L(0); PG8_BAR; PG8_MMA(1, 0, At, B0); PG8_MMA(1, 1, At, B1); PG8_BAR; PG8_SCHED;
            PG8_LDB(B0, 1, 0); PG8_LDB(B1, 1, 1); PG8_SCHED; PG8_LDA(At, 1, 0); PG8_STAGE(PG8_SA(0, 1), a2 + hstep, voffA);
            PG8_WAIT_V(8); PG8_WAIT_L(0); PG8_BAR; PG8_MMA(0, 0, At, B0); PG8_MMA(0, 1, At, B1); PG8_BAR; PG8_SCHED;
            PG8_LDA(At, 1, 1); PG8_STAGE(PG8_SB(1, 0), b3, voffB); PG8_STAGE(PG8_SB(1, 1), b3 + hstep, voffB); PG8_STAGE(PG8_SA(1, 0), a3, voffA);
            PG8_WAIT_V(8); PG8_WAIT_L(0); PG8_BAR; PG8_MMA(1, 0, At, B0); PG8_MMA(1, 1, At, B1); PG8_BAR; PG8_SCHED;
            } else {
            PG8_LDB(B0, 0, 0); PG8_SCHED; PG8_LDA(At, 0, 0); PG8_STAGE(PG8_SA(1, 1), a1 + hstep, voffA);
            PG8_WAIT_L(8); PG8_BAR; PG8_WAIT_L(0); PG8_MMA(0, 0, At, B0); PG8_BAR; PG8_SCHED;
            PG8_LDB(B1, 0, 1); PG8_STAGE(PG8_SB(0, 0), b2, voffB);
            PG8_BAR; PG8_WAIT_L(0); PG8_MMA(0, 1, At, B1); PG8_BAR;
            PG8_LDA(At, 0, 1); PG8_STAGE(PG8_SA(0, 0), a2, voffA);
            PG8_BAR; PG8_WAIT_L(0); PG8_MMA(1, 0, At, B0); PG8_BAR; PG8_SCHED;
            PG8_STAGE(PG8_SB(0, 1), b2 + hstep, voffB);
            PG8_WAIT_V(6); PG8_BAR; PG8_MMA(1, 1, At, B1); PG8_BAR;
            PG8_LDB(B0, 1, 0); PG8_SCHED; PG8_LDA(At, 1, 0); PG8_STAGE(PG8_SA(0, 1), a2 + hstep, voffA);
            PG8_WAIT_L(8); PG8_BAR; PG8_WAIT_L(0); PG8_MMA(0, 0, At, B0); PG8_BAR; PG8_SCHED;
            PG8_LDB(B1, 1, 1); PG8_STAGE(PG8_SB(1, 0), b3, voffB);
            PG8_BAR; PG8_WAIT_L(0); PG8_MMA(0, 1, At, B1); PG8_BAR;
            PG8_LDA(At, 1, 1); PG8_STAGE(PG8_SA(1, 0), a3, voffA);
            PG8_BAR; PG8_WAIT_L(0); PG8_MMA(1, 0, At, B0); PG8_BAR; PG8_SCHED;
            PG8_STAGE(PG8_SB(1, 1), b3 + hstep, voffB);
            PG8_WAIT_V(6); PG8_BAR; PG8_MMA(1, 1, At, B1); PG8_BAR;
            }
        }
        if constexpr (ALIGN_EPI) { if (wr == 0) PG8_BAR; }
        if constexpr (!Epi::AFTER_DRAIN) { E(acc, cur, wr, wc, fr, fq); S.done(cur); }
        if (!has_next) break;
#pragma unroll
        for (int a = 0; a < 2; ++a)
#pragma unroll
            for (int b = 0; b < 2; ++b)
#pragma unroll
                for (int m = 0; m < 4; ++m)
#pragma unroll
                    for (int n = 0; n < 2; ++n) acc[a][b][m][n] = (f32x4){0.f, 0.f, 0.f, 0.f};
        cur = nxt; cA = nA; cB = nB; ++ui;
        if constexpr (ALIGN_EPI) { if (wr == 1) PG8_BAR; }
    }
    PG8_WAIT_V(0);
    if constexpr (!ALIGN_EPI) { if (wr == 0) PG8_BAR; }
    PG8_BAR;
    if constexpr (Epi::AFTER_DRAIN) { E.fused(acc, cur, wr, wc, fr, fq, lds, wid, lane); S.done(cur); }
#undef PG8_SA
#undef PG8_SB
#undef PG8_STAGE
#undef PG8_LDA
#undef PG8_LDB
#undef PG8_MMA
#undef PG8_WAIT_V
#undef PG8_WAIT_L
#undef PG8_BAR
#undef PG8_SCHED
}
}

#ifndef MK_PER_PHASE
#define MK_PER_PHASE 0
#endif
#ifndef MK_PROBE
#define MK_PROBE 0
#endif
#define LAS __attribute__((address_space(3)))
using pg8::bf16_t; using pg8::f32x4; using pg8::u32x4; using pg8::bf16x8;
typedef unsigned u32x2 __attribute__((ext_vector_type(2)));

constexpr int M = 16384, SEQ = 4096, D = 1024, FF = 2816, DIN = 1792, NLAYER = 2;
constexpr int ZLD = 1408;
constexpr float EPS = 1e-6f;
constexpr int NPHASE = 16;
constexpr size_t MiB = 1u << 20;
constexpr size_t WS_SSQ = 1 * MiB, WS_W = 2 * MiB, WS_XB = 80 * MiB, WS_H = 112 * MiB, WS_Z = 112 * MiB, WS_Y = 156 * MiB;
constexpr size_t W_GU1 = 0, W_D1 = 11534336, W_IN = 17301504, W_OUT = 20971520, W_GU2 = 23068672, W_D2 = 34603008, W_LAYER = 40370176;
static_assert(WS_W + 2 * W_LAYER <= WS_XB && WS_Z + (size_t)M * ZLD * 2 <= WS_Y && WS_Y + (size_t)M * D * 2 <= WS_H + (size_t)M * FF * 2 && WS_H + (size_t)M * FF * 2 <= 256 * MiB, "ws map");
constexpr int LDS_BYTES = 147456;
constexpr int VT_LD = 136, PW_LD = 72;
constexpr int L_VT = 0, L_CW = 52224, L_PW = L_CW + 32 * 384 * 4;
static_assert(L_PW + 4 * 64 * PW_LD * 2 <= LDS_BYTES, "lds map");

__device__ __forceinline__ unsigned f2bf(float f) { unsigned u = __builtin_bit_cast(unsigned, f); return (u + 0x7fffu + ((u >> 16) & 1u)) >> 16; }
__device__ __forceinline__ unsigned pk2(float lo, float hi) { return f2bf(lo) | (f2bf(hi) << 16); }
__device__ __forceinline__ float bf_lo(unsigned w) { return __uint_as_float(w << 16); }
__device__ __forceinline__ float bf_hi(unsigned w) { return __uint_as_float(w & 0xffff0000u); }
__device__ __forceinline__ float wave_sum(float v) {
#pragma unroll
    for (int o = 1; o < 64; o <<= 1) v += __shfl_xor(v, o);
    return v;
}
__device__ __forceinline__ void ld6(const bf16_t* p, float (&v)[6]) {
    const unsigned* q = (const unsigned*)p; const unsigned a = q[0], b = q[1], c = q[2];
    v[0] = bf_lo(a); v[1] = bf_hi(a); v[2] = bf_lo(b); v[3] = bf_hi(b); v[4] = bf_lo(c); v[5] = bf_hi(c);
}

__device__ __forceinline__ int dst_row(int mode, int c) {
    if (mode == 0) return c;
    if (mode == 1) return 256 * (c >> 7) + (c & 127);
    if (mode == 2) return 256 * (c >> 7) + 128 + (c & 127);
    if (c < 768 || c >= 1536) return c;
    if (c < 1152) { const int j = c - 768; return 768 + 256 * (j >> 7) + (j & 127); }
    { const int j = c - 1152; return 768 + 256 * (j >> 7) + 128 + (j & 127); }
}
__device__ __forceinline__ void p0_transpose_item(const float* W, int K, int N, bf16_t* WT, int mode, const float* gk, LAS float* scr, int item, int lane) {
    const int nblk = N / 32, kb = item / nblk, nb = item % nblk, k0 = 64 * kb, n0 = 32 * nb;
#pragma unroll 8
    for (int i = 0; i < 32; ++i) { const int kk = 2 * i + (lane >> 5); float w = W[(size_t)(k0 + kk) * N + n0 + (lane & 31)]; if (gk) w *= gk[k0 + kk]; scr[kk * 33 + (lane & 31)] = w; }
    asm volatile("s_waitcnt lgkmcnt(0)" ::: "memory");
    const int c = lane & 7; const int dr0 = dst_row(mode, n0);
#pragma unroll
    for (int j = 0; j < 4; ++j) { const int n = (lane >> 3) + 8 * j; const LAS float* s = scr + (8 * c) * 33 + n;
        u32x4 o; o.x = pk2(s[0 * 33], s[1 * 33]); o.y = pk2(s[2 * 33], s[3 * 33]); o.z = pk2(s[4 * 33], s[5 * 33]); o.w = pk2(s[6 * 33], s[7 * 33]);
        *(u32x4*)(WT + (size_t)(dr0 + n) * K + k0 + 8 * c) = o; }
    asm volatile("s_waitcnt lgkmcnt(0)" ::: "memory");
}

#define XB_TMO      128
#define XB_XCNT(j)  (256  + 64 * (j))
#define XB_XSUB(j)  (1280 + 64 * (j))
#define XB_XGEN(j)  (2304 + 64 * (j))
#define XB_TOP      3328
#define XB_TOPGEN   3392
#define XCD_BAR_WORDS 3456
#define XB_SPIN_CAP (1u << 18)

__device__ __forceinline__ unsigned xb_ld(unsigned* p)              { return __hip_atomic_load(p, __ATOMIC_RELAXED, __HIP_MEMORY_SCOPE_AGENT); }
__device__ __forceinline__ unsigned xb_add(unsigned* p, unsigned v) { return __hip_atomic_fetch_add(p, v, __ATOMIC_RELAXED, __HIP_MEMORY_SCOPE_AGENT); }
__device__ __forceinline__ unsigned xb_xcc_id() { return (unsigned)__builtin_amdgcn_s_getreg((3 << 11) | 20) & 0xFu; }
#define XB_SPIN(cond, bar) do { unsigned _sp = 0; while (cond) { __builtin_amdgcn_s_sleep(1); \
    if ((++_sp & 255u) == 0u) { if (xb_ld(&(bar)[XB_TMO])) break; if (_sp > XB_SPIN_CAP) { atomicAdd(&(bar)[XB_TMO], 1u); break; } } } } while (0)

struct XcdBarrier {
    unsigned* bar; unsigned x;
    volatile LAS unsigned* st;
};

__device__ __forceinline__ XcdBarrier xcd_barrier_post(unsigned* bar, volatile LAS unsigned* st) {
    XcdBarrier b; b.bar = bar; b.x = xb_xcc_id(); b.st = st;
    if (threadIdx.x == 0) (void)xb_add(&bar[XB_XCNT(b.x)], 1u);
    return b;
}
__device__ __forceinline__ void xcd_barrier_complete(unsigned* bar, unsigned x, unsigned& nloc, unsigned& nx) {
    const unsigned G = gridDim.x * gridDim.y * gridDim.z;
    unsigned sum, cnt, mine, sp = 0u;
    for (;;) {
        sum = 0u; cnt = 0u; mine = 0u;
#pragma unroll
        for (unsigned j = 0; j < 16; ++j) { const unsigned c = xb_ld(&bar[XB_XCNT(j)]); sum += c; cnt += (c > 0u) ? 1u : 0u; mine = (j == x) ? c : mine; }
        if (sum == G) break;
        __builtin_amdgcn_s_sleep(1);
        if ((++sp & 255u) == 0u) { if (xb_ld(&bar[XB_TMO])) break; if (sp > XB_SPIN_CAP) { atomicAdd(&bar[XB_TMO], 1u); break; } }
    }
    nloc = mine > 0u ? mine : 1u; nx = cnt > 0u ? cnt : 1u;
}

__device__ __forceinline__ void xcd_barrier(const XcdBarrier& b) {
    asm volatile("s_waitcnt vmcnt(0)" ::: "memory");
    __syncthreads();
    if (threadIdx.x == 0) {
        unsigned* bar = b.bar;
        __builtin_amdgcn_s_waitcnt(0);
        unsigned nloc = b.st[0], nx = b.st[1];
        if (nloc == 0u) { xcd_barrier_complete(bar, b.x, nloc, nx); b.st[0] = nloc; b.st[1] = nx; }
        const unsigned old = xb_add(&bar[XB_XSUB(b.x)], 1u);
        const unsigned gen = old / nloc;
        if (old + 1u == (gen + 1u) * nloc) {
            __builtin_amdgcn_fence(__ATOMIC_RELEASE, "agent");
            asm volatile("s_waitcnt vmcnt(0)" ::: "memory");
            const unsigned og = xb_add(&bar[XB_TOP], 1u);
            const unsigned tg = og / nx;
            if (og + 1u == (tg + 1u) * nx) xb_add(&bar[XB_TOPGEN], 1u);
            else XB_SPIN(xb_ld(&bar[XB_TOPGEN]) == tg, bar);
            __builtin_amdgcn_fence(__ATOMIC_ACQUIRE, "agent");
            xb_add(&bar[XB_XGEN(b.x)], 1u);
            asm volatile("s_waitcnt vmcnt(0)" ::: "memory");
        } else {
            XB_SPIN(xb_ld(&bar[XB_XGEN(b.x)]) == gen, bar);
            __builtin_amdgcn_fence(__ATOMIC_ACQUIRE, "agent");
            asm volatile("s_waitcnt vmcnt(0)" ::: "memory");
        }
    }
    __syncthreads();
}

struct Args { const float* in[23]; float* out; unsigned char* ws; int ph_lo, ph_hi; };

__device__ __forceinline__ void prologue_phase(const Args& args, LAS unsigned char* lds, int lane, int wave, int G, int bx) {
    unsigned char* ws = args.ws;
    LAS float* scr = (LAS float*)(lds + wave * 16384);
    const int gw = bx * 8 + wave, NGW = G * 8;
    constexpr int I_G = (D / 64) * (FF / 32), I_D = (FF / 64) * (D / 32), I_IN = (D / 64) * (DIN / 32), I_OUT = (D / 64) * (D / 32);
    constexpr int I_LAYER = 4 * I_G + 2 * I_D + I_IN + I_OUT;
    for (int it = gw; it < NLAYER * I_LAYER; it += NGW) {
        const int l = it / I_LAYER; int r = it % I_LAYER;
        unsigned char* wl = ws + WS_W + (size_t)l * W_LAYER;
        const size_t oG = (size_t)l * D * FF, oD = (size_t)l * FF * D;
        if (r < I_G) { p0_transpose_item(args.in[2] + oG, D, FF, (bf16_t*)(wl + W_GU1), 1, args.in[1] + l * D, scr, r, lane); continue; } r -= I_G;
        if (r < I_G) { p0_transpose_item(args.in[3] + oG, D, FF, (bf16_t*)(wl + W_GU1), 2, args.in[1] + l * D, scr, r, lane); continue; } r -= I_G;
        if (r < I_D) { p0_transpose_item(args.in[4] + oD, FF, D, (bf16_t*)(wl + W_D1), 0, nullptr, scr, r, lane); continue; } r -= I_D;
        if (r < I_IN) { p0_transpose_item(args.in[6] + (size_t)l * D * DIN, D, DIN, (bf16_t*)(wl + W_IN), 3, args.in[5] + l * D, scr, r, lane); continue; } r -= I_IN;
        if (r < I_OUT) { p0_transpose_item(args.in[17] + (size_t)l * D * D, D, D, (bf16_t*)(wl + W_OUT), 0, nullptr, scr, r, lane); continue; } r -= I_OUT;
        if (r < I_G) { p0_transpose_item(args.in[19] + oG, D, FF, (bf16_t*)(wl + W_GU2), 1, args.in[18] + l * D, scr, r, lane); continue; } r -= I_G;
        if (r < I_G) { p0_transpose_item(args.in[20] + oG, D, FF, (bf16_t*)(wl + W_GU2), 2, args.in[18] + l * D, scr, r, lane); continue; } r -= I_G;
        p0_transpose_item(args.in[21] + oD, FF, D, (bf16_t*)(wl + W_D2), 0, nullptr, scr, r, lane);
    }
    const float* x = args.in[0]; bf16_t* xb = (bf16_t*)(ws + WS_XB); float* ssq = (float*)(ws + WS_SSQ);
    for (int m = gw; m < M; m += NGW) {
        const f32x4* xr = (const f32x4*)(x + (size_t)m * D) + lane;
        f32x4 v[4]; float s = 0.f;
#pragma unroll
        for (int j = 0; j < 4; ++j) { v[j] = xr[64 * j]; s += (v[j][0] * v[j][0] + v[j][1] * v[j][1]) + (v[j][2] * v[j][2] + v[j][3] * v[j][3]); }
        s = wave_sum(s);
        u32x2* o8 = (u32x2*)(xb + (size_t)m * D) + lane;
#pragma unroll
        for (int j = 0; j < 4; ++j) { u32x2 o; o.x = pk2(v[j][0], v[j][1]); o.y = pk2(v[j][2], v[j][3]); o8[64 * j] = o; }
        if (lane < 16) ssq[(size_t)m * 16 + lane] = (lane == 0) ? s : 0.f;
    }
}

__device__ __forceinline__ void final_phase(const Args& args, int lane, int wave, int G, int bx) {
    const float* ssq = (const float*)(args.ws + WS_SSQ); const float* g = args.in[22]; float* out = args.out;
    const int gw = bx * 8 + wave, NGW = G * 8;
    f32x4 gv[4];
#pragma unroll
    for (int j = 0; j < 4; ++j) gv[j] = ((const f32x4*)g)[lane + 64 * j];
    for (int m = gw; m < M; m += NGW) {
        float s = (lane < 16) ? ssq[(size_t)m * 16 + lane] : 0.f;
        s = wave_sum(s);
        const float rs = 1.0f / sqrtf(s * (1.0f / D) + EPS);
        f32x4* xr = (f32x4*)(out + (size_t)m * D) + lane;
#pragma unroll
        for (int j = 0; j < 4; ++j) { f32x4 v = xr[64 * j]; v = v * rs * gv[j]; xr[64 * j] = v; }
    }
}

__device__ __forceinline__ void mixer_phase(LAS unsigned char* lds, const bf16_t* Z, bf16_t* Y,
        const float* sgu_g, const float* sgu_b, const float* wsp, const float* bsp,
        const float* cw, const float* cbias, const float* cln_g, const float* cln_b,
        const float* pw, const float* ps, int tid, int lane, int wave, int G, int bx) {
    LAS bf16_t* VT = (LAS bf16_t*)(lds + L_VT);
    LAS float* CW = (LAS float*)(lds + L_CW);
    LAS bf16_t* PW = (LAS bf16_t*)(lds + L_PW);
    const int fr = lane & 15, kq = lane >> 4;
    for (int unit = bx; unit < 256; unit += G) {
        const int chunk = unit >> 1, half = unit & 1;
        const int cb0 = chunk * 128;
        __syncthreads();
        for (int i = tid; i < 32 * 384 / 4; i += 512) ((LAS f32x4*)CW)[i] = (i < 31 * 384 / 4) ? ((const f32x4*)cw)[i] : (f32x4){0.f, 0.f, 0.f, 0.f};
        for (int i = tid; i < 4 * 64 * 64; i += 512) { const int g = i >> 12, c = (i >> 6) & 63, d = i & 63; PW[(g * 64 + d) * PW_LD + c] = (bf16_t)f2bf(pw[i]); }
        {
            float gg[6], bb[6];
#pragma unroll
            for (int k = 0; k < 6; ++k) { gg[k] = sgu_g[6 * lane + k]; bb[k] = sgu_b[6 * lane + k]; }
#pragma unroll 4
            for (int qi = 0; qi < 16; ++qi) {
                const int q = 16 * wave + qi;
                float v[6]; ld6(Z + (size_t)(cb0 + q) * ZLD + 384 + 6 * lane, v);
                float s = ((v[0] + v[1]) + (v[2] + v[3])) + (v[4] + v[5]);
                const float mean = wave_sum(s) * (1.0f / 384.0f);
                float s2 = 0.f;
#pragma unroll
                for (int k = 0; k < 6; ++k) { v[k] -= mean; s2 += v[k] * v[k]; }
                const float rstd = 1.0f / sqrtf(wave_sum(s2) * (1.0f / 384.0f) + EPS);
                if ((lane >> 5) == half) {
#pragma unroll
                    for (int k = 0; k < 6; ++k) VT[(6 * (lane & 31) + k) * VT_LD + q] = (bf16_t)f2bf(v[k] * rstd * gg[k] + bb[k]);
                }
            }
        }
        __syncthreads();
        {
            const int p = 16 * wave + fr;
            const int nks = (wave >> 1) + 1;
#pragma unroll 1
            for (int hl = 0; hl < 3; ++hl) {
                const int h = 3 * half + hl;
                f32x4 accd[4];
#pragma unroll
                for (int ct = 0; ct < 4; ++ct) accd[ct] = (f32x4){0.f, 0.f, 0.f, 0.f};
                for (int ks = 0; ks < nks; ++ks) {
                    const int q0 = 32 * ks + 8 * kq;
                    const float* wp = wsp + ((size_t)h * 128 + p) * 128 + q0;
                    const f32x4 w0 = *(const f32x4*)wp, w1 = *(const f32x4*)(wp + 4);
                    u32x4 bw;
                    bw.x = pk2(q0 + 0 <= p ? w0[0] : 0.f, q0 + 1 <= p ? w0[1] : 0.f); bw.y = pk2(q0 + 2 <= p ? w0[2] : 0.f, q0 + 3 <= p ? w0[3] : 0.f);
                    bw.z = pk2(q0 + 4 <= p ? w1[0] : 0.f, q0 + 5 <= p ? w1[1] : 0.f); bw.w = pk2(q0 + 6 <= p ? w1[2] : 0.f, q0 + 7 <= p ? w1[3] : 0.f);
                    const bf16x8 bfrag = __builtin_bit_cast(bf16x8, bw);
#pragma unroll
                    for (int ct = 0; ct < 4; ++ct) {
                        const bf16x8 afrag = *(const LAS bf16x8*)(VT + (hl * 64 + 16 * ct + fr) * VT_LD + q0);
                        accd[ct] = __builtin_amdgcn_mfma_f32_16x16x32_bf16(afrag, bfrag, accd[ct], 0, 0, 0);
                    }
                }
                const float bs = bsp[h * 128 + p];
                const size_t trow = (size_t)(cb0 + p);
#pragma unroll
                for (int ct = 0; ct < 4; ++ct) {
                    const int c0 = h * 64 + 16 * ct + 4 * kq;
                    const u32x2 uu = *(const u32x2*)(Z + trow * ZLD + c0);
                    u32x2 o;
                    o.x = pk2(bf_lo(uu.x) * (accd[ct][0] + bs), bf_hi(uu.x) * (accd[ct][1] + bs));
                    o.y = pk2(bf_lo(uu.y) * (accd[ct][2] + bs), bf_hi(uu.y) * (accd[ct][3] + bs));
                    *(u32x2*)(Y + trow * D + c0) = o;
                }
            }
        }
        {
            float cbv[6], lg[6], lb[6];
#pragma unroll
            for (int k = 0; k < 6; ++k) { cbv[k] = cbias[6 * lane + k]; lg[k] = cln_g[6 * lane + k]; lb[k] = cln_b[6 * lane + k]; }
#pragma unroll 1
            for (int ti = 0; ti < 8; ++ti) {
                const int t = cb0 + 64 * half + 8 * wave + ti, tpos = t & (SEQ - 1);
                float a[6];
#pragma unroll
                for (int k = 0; k < 6; ++k) a[k] = cbv[k];
#pragma unroll 1
                for (int jb = 0; jb < 32; jb += 8) {
#pragma unroll
                    for (int jj = 0; jj < 8; ++jj) {
                        const int j = jb + jj; const int tt = tpos - 30 + j;
                        const bool valid = (tt >= 0) && (j < 31);
                        const int row = valid ? (t - 30 + j) : t;
                        float x[6]; ld6(Z + (size_t)row * ZLD + 768 + 6 * lane, x);
                        const LAS float* wr_ = CW + j * 384 + 6 * lane;
                        const float sc = valid ? 1.0f : 0.0f;
#pragma unroll
                        for (int k = 0; k < 6; ++k) a[k] += (wr_[k] * sc) * x[k];
                    }
                }
                float s = ((a[0] + a[1]) + (a[2] + a[3])) + (a[4] + a[5]);
                const float mean = wave_sum(s) * (1.0f / 384.0f);
                float s2 = 0.f;
#pragma unroll
                for (int k = 0; k < 6; ++k) { a[k] -= mean; s2 += a[k] * a[k]; }
                const float rstd = 1.0f / sqrtf(wave_sum(s2) * (1.0f / 384.0f) + EPS);
                float y[6];
#pragma unroll
                for (int k = 0; k < 6; ++k) { const float v = a[k] * rstd * lg[k] + lb[k]; y[k] = v / (1.0f + __expf(-v)); }
                unsigned* yo = (unsigned*)(Y + (size_t)t * D + 384 + 6 * lane);
                yo[0] = pk2(y[0], y[1]); yo[1] = pk2(y[2], y[3]); yo[2] = pk2(y[4], y[5]);
            }
        }
        {
            const int t = cb0 + 64 * half + 16 * (wave & 3) + fr, tpos = t & (SEQ - 1);
#pragma unroll 1
            for (int gi = 0; gi < 2; ++gi) {
                const int g = 2 * (wave >> 2) + gi, win = 2 << g;
                const float inv = 1.0f / (float)((tpos + 1 < win) ? (tpos + 1) : win);
                f32x4 accd[4];
#pragma unroll
                for (int dt = 0; dt < 4; ++dt) accd[dt] = (f32x4){0.f, 0.f, 0.f, 0.f};
#pragma unroll 1
                for (int ks = 0; ks < 2; ++ks) {
                    const int c0 = g * 64 + 32 * ks + 8 * kq;
                    const bf16_t* pp = Z + (size_t)t * ZLD + 1152 + c0;
                    const u32x4 cur = *(const u32x4*)pp;
                    float s[8] = {bf_lo(cur.x), bf_hi(cur.x), bf_lo(cur.y), bf_hi(cur.y), bf_lo(cur.z), bf_hi(cur.z), bf_lo(cur.w), bf_hi(cur.w)};
                    for (int i = 1; i < win; ++i) {
                        const bool valid = (i <= tpos);
                        const u32x4 r = *(const u32x4*)(pp - (valid ? (size_t)i * ZLD : 0));
                        const float sc = valid ? 1.0f : 0.0f;
                        s[0] += sc * bf_lo(r.x); s[1] += sc * bf_hi(r.x); s[2] += sc * bf_lo(r.y); s[3] += sc * bf_hi(r.y);
                        s[4] += sc * bf_lo(r.z); s[5] += sc * bf_hi(r.z); s[6] += sc * bf_lo(r.w); s[7] += sc * bf_hi(r.w);
                    }
                    u32x4 bw;
                    bw.x = pk2(s[0] * inv - bf_lo(cur.x), s[1] * inv - bf_hi(cur.x)); bw.y = pk2(s[2] * inv - bf_lo(cur.y), s[3] * inv - bf_hi(cur.y));
                    bw.z = pk2(s[4] * inv - bf_lo(cur.z), s[5] * inv - bf_hi(cur.z)); bw.w = pk2(s[6] * inv - bf_lo(cur.w), s[7] * inv - bf_hi(cur.w));
                    const bf16x8 bfrag = __builtin_bit_cast(bf16x8, bw);
#pragma unroll
                    for (int dt = 0; dt < 4; ++dt) {
                        const bf16x8 afrag = *(const LAS bf16x8*)(PW + (g * 64 + 16 * dt + fr) * PW_LD + 32 * ks + 8 * kq);
                        accd[dt] = __builtin_amdgcn_mfma_f32_16x16x32_bf16(afrag, bfrag, accd[dt], 0, 0, 0);
                    }
                }
#pragma unroll
                for (int dt = 0; dt < 4; ++dt) {
                    const int d0 = g * 64 + 16 * dt + 4 * kq;
                    const f32x4 sc = *(const f32x4*)(ps + d0);
                    u32x2 o; o.x = pk2(accd[dt][0] * sc[0], accd[dt][1] * sc[1]); o.y = pk2(accd[dt][2] * sc[2], accd[dt][3] * sc[3]);
                    *(u32x2*)(Y + (size_t)t * D + 768 + d0) = o;
                }
            }
        }
    }
}

__global__ void __launch_bounds__(512, 2) mk_fwd(Args args) {
    extern __shared__ __attribute__((aligned(16))) unsigned char lds_raw[];
    LAS unsigned char* lds = (LAS unsigned char*)lds_raw;
    const int tid = threadIdx.x, lane = tid & 63, wave = __builtin_amdgcn_readfirstlane(tid >> 6);
    const int G = gridDim.x, bx = blockIdx.x;
    unsigned* barw = (unsigned*)args.ws;
    volatile LAS unsigned* bst = (volatile LAS unsigned*)(lds + LDS_BYTES - 16);
    if (tid < 2) bst[tid] = 0u;
    if (bx == 0) for (int i = tid; i < XCD_BAR_WORDS; i += 512) __hip_atomic_store(barw + i, 0u, __ATOMIC_RELAXED, __HIP_MEMORY_SCOPE_AGENT);
    __syncthreads();
    if (args.ph_lo == 0) { prologue_phase(args, lds, lane, wave, G, bx);
#if MK_PROBE == 1
        __syncthreads(); prologue_phase(args, lds, lane, wave, G, bx);
#endif
        if (args.ph_hi > 1) cg::this_grid().sync(); }
    XcdBarrier xbar = xcd_barrier_post(barw, bst);
    const int plo = args.ph_lo < 1 ? 1 : args.ph_lo, phi = args.ph_hi > NPHASE - 1 ? NPHASE - 1 : args.ph_hi;
#pragma unroll 1
    for (int ph = plo; ph < phi; ++ph) {
        int tid_ = threadIdx.x; asm volatile("" : "+v"(tid_));
        const int lane_ = tid_ & 63, wave_ = __builtin_amdgcn_readfirstlane(tid_ >> 6);
        unsigned char* wsp_ = args.ws; asm volatile("" : "+s"(wsp_));
        bf16_t* XB = (bf16_t*)(wsp_ + WS_XB); bf16_t* HB = (bf16_t*)(wsp_ + WS_H); bf16_t* ZB = (bf16_t*)(wsp_ + WS_Z); bf16_t* YB = (bf16_t*)(wsp_ + WS_Y);
        float* SSQ = (float*)(wsp_ + WS_SSQ);
        const int l = (ph - 1) / 7, s = (ph - 1) % 7;
        unsigned char* wl = wsp_ + WS_W + (size_t)l * W_LAYER;
        if (s == 0 || s == 5) {
            pg8::Gemm g{XB, (const bf16_t*)(wl + (s == 0 ? W_GU1 : W_GU2)), M, 2 * FF, D};
            pg8::StaticOrder S; S.init(M, 2 * FF, G, bx);
            pg8::EpiSwiGLU E{HB, FF, SSQ};
            pg8::gemm_phase<pg8::EpiSwiGLU, pg8::StaticOrder, true, true>(lds, g, S, E);
#if MK_PROBE == 4
            __syncthreads(); pg8::gemm_phase<pg8::EpiSwiGLU, pg8::StaticOrder, true, true>(lds, g, S, E);
#endif
        } else if (s == 1 || s == 6 || s == 4) {
            pg8::Gemm g{s == 4 ? YB : HB, (const bf16_t*)(wl + (s == 1 ? W_D1 : (s == 6 ? W_D2 : W_OUT))), M, D, s == 4 ? D : FF};
            pg8::StaticOrder S; S.init(M, D, G, bx);
            pg8::EpiRes E{(l == 0 && s == 1) ? args.in[0] : args.out, args.out, XB, SSQ, s == 4 ? 1.0f : 0.5f};
            pg8::gemm_phase<pg8::EpiRes, pg8::StaticOrder, true, true>(lds, g, S, E);
        } else if (s == 2) {
            pg8::Gemm g{XB, (const bf16_t*)(wl + W_IN), M, DIN, D};
            pg8::StaticOrder S; S.init(M, DIN, G, bx);
            pg8::EpiWin E{ZB, ZLD, SSQ};
            pg8::gemm_phase<pg8::EpiWin, pg8::StaticOrder, true, true>(lds, g, S, E);
        } else {
            mixer_phase(lds, ZB, YB, args.in[7] + l * 384, args.in[8] + l * 384, args.in[9] + (size_t)l * 6 * 128 * 128, args.in[10] + l * 6 * 128,
                        args.in[11] + (size_t)l * 31 * 384, args.in[12] + l * 384, args.in[13] + l * 384, args.in[14] + l * 384,
                        args.in[15] + (size_t)l * 4 * 64 * 64, args.in[16] + l * 256, tid_, lane_, wave_, G, bx);
#if MK_PROBE == 2
            mixer_phase(lds, ZB, YB, args.in[7] + l * 384, args.in[8] + l * 384, args.in[9] + (size_t)l * 6 * 128 * 128, args.in[10] + l * 6 * 128,
                        args.in[11] + (size_t)l * 31 * 384, args.in[12] + l * 384, args.in[13] + l * 384, args.in[14] + l * 384,
                        args.in[15] + (size_t)l * 4 * 64 * 64, args.in[16] + l * 256, tid_, lane_, wave_, G, bx);
#endif
        }
        if (ph + 1 < args.ph_hi) { xcd_barrier(xbar);
#if MK_PROBE == 3
            xcd_barrier(xbar);
#endif
        }
    }
    if (args.ph_hi == NPHASE) final_phase(args, lane, wave, G, bx);
}

extern "C" void kernel_launch(void* const* d_in, const int* in_sizes, int n_in, void* d_out, int out_size, void* d_ws, size_t ws_size, hipStream_t stream) {
    static int grid = 0;
    if (grid == 0) {
        int dev = 0, cus = 0, per_cu = 0;
        hipGetDevice(&dev);
        hipDeviceGetAttribute(&cus, hipDeviceAttributeMultiprocessorCount, dev);
        if (hipFuncSetAttribute((const void*)mk_fwd, hipFuncAttributeMaxDynamicSharedMemorySize, LDS_BYTES) != hipSuccess) fprintf(stderr, "kernel_launch: hipFuncSetAttribute failed\n");
        if (hipOccupancyMaxActiveBlocksPerMultiprocessor(&per_cu, (const void*)mk_fwd, 512, LDS_BYTES) != hipSuccess || per_cu < 1) { fprintf(stderr, "kernel_launch: occupancy query says %d\n", per_cu); per_cu = 1; }
        (void)hipGetLastError();
        grid = cus * 1;
        if (grid <= 0) grid = 256;
    }
    Args a{};
    for (int i = 0; i < 23; ++i) a.in[i] = (const float*)d_in[i];
    a.out = (float*)d_out; a.ws = (unsigned char*)d_ws;
#if MK_PER_PHASE
    for (int ph = 0; ph < NPHASE; ++ph) { a.ph_lo = ph; a.ph_hi = ph + 1; hipLaunchKernelGGL(mk_fwd, dim3(grid), dim3(512), LDS_BYTES, stream, a); }
#else
    a.ph_lo = 0; a.ph_hi = NPHASE;
    void* kargs[] = {&a};
    const hipError_t e = hipLaunchCooperativeKernel((const void*)mk_fwd, dim3(grid), dim3(512), kargs, LDS_BYTES, stream);
    if (e != hipSuccess) fprintf(stderr, "kernel_launch: cooperative launch failed: %s (grid %d)\n", hipGetErrorString(e), grid);
#endif
}
```

```cpp
#include <hip/hip_runtime.h>
#include <hip/hip_cooperative_groups.h>
#include <cstdio>
#include <cstdint>
namespace cg = cooperative_groups;
namespace pg8 {
#define PG8_LAS __attribute__((address_space(3)))
typedef unsigned short bf16_t;
typedef short bf16x8 __attribute__((ext_vector_type(8)));
typedef float f32x4 __attribute__((ext_vector_type(4)));
typedef unsigned u32x4 __attribute__((ext_vector_type(4)));
constexpr int BM = 256, BK = 64, HALF = 128, HTB = HALF * BK * 2  , STAGE_BYTES = 8 * HTB, NXCD = 8, WGM = 8;

__host__ __device__ __forceinline__ int lds_byte(int r, int c) { const int st = (r >> 4) * 2 + (c >> 5), rr = r & 15, cc = c & 31, ob = rr * 64 + cc * 2; return st * 1024 + (ob ^ (((ob >> 9) & 1) << 5)); }
__host__ __device__ __forceinline__ void stage_rc(int b, int& R, int& C) { const int st = b / 1024, sb = b % 1024, swz = sb ^ (((sb >> 9) & 1) << 5); R = (st >> 1) * 16 + swz / 64; C = (st & 1) * 32 + (swz % 64) / 2; }
__host__ __device__ __forceinline__ int perm32(int rho) { const int n = rho >> 4, i = rho & 15; return 8 * (i >> 2) + 4 * n + (i & 3); }

struct Unit { int pm, pn; };
struct Gemm { const bf16_t* A; const bf16_t* Bt; int M, N, K; };

struct StaticOrder {
    int nM, nN, nwg, G, c;
    __host__ __device__ void init(int M, int N, int G_, int c_) { nM = M / BM; nN = N / BM; nwg = nM * nN; G = G_; c = c_; }
    __host__ __device__ bool next(int i, Unit& u) const {
        const long L = (long)i * G + c; if (L >= nwg) return false;
        int wgid = (int)L; { const int q = nwg / NXCD, r = nwg % NXCD, xcd = wgid % NXCD, off = wgid / NXCD; wgid = (xcd < r ? xcd * (q + 1) : r * (q + 1) + (xcd - r) * q) + off; }
        const int nig = WGM * nN, gid = wgid / nig, fm = gid * WGM, gsz = (nM - fm) < WGM ? (nM - fm) : WGM;
        u.pm = fm + ((wgid % nig) % gsz); u.pn = (wgid % nig) / gsz; return true;
    }
    __device__ __forceinline__ void a_ready(const Unit&) const {}
    __device__ __forceinline__ void done(const Unit&) const {}
};

__device__ __forceinline__ unsigned cvt_pk_bf16(float lo, float hi) { unsigned r; asm volatile("v_cvt_pk_bf16_f32 %0, %1, %2" : "=v"(r) : "v"(lo), "v"(hi)); return r; }
typedef float f32x2 __attribute__((ext_vector_type(2)));
__device__ __forceinline__ f32x2 gelu_pk(f32x2 v) {
    const f32x2 av = __builtin_elementwise_abs(v), d = av * 0.2316418882f + 1.0f;
    f32x2 t; t.x = __builtin_amdgcn_rcpf(d.x); t.y = __builtin_amdgcn_rcpf(d.y);
    f32x2 q = t * 0.5307027145f + (-0.7265760135f); q = q * t + 0.7107068705f; q = q * t + (-0.142248368f); q = q * t + 0.127414796f; q = q * t;
    const f32x2 s = (v * v) * (-0.72134752044f);
    f32x2 e; e.x = __builtin_amdgcn_exp2f(s.x); e.y = __builtin_amdgcn_exp2f(s.y);
    const f32x2 m = v * (q * e), r = v - m;
    f32x2 o; o.x = v.x < 0.f ? m.x : r.x; o.y = v.y < 0.f ? m.y : r.y; return o;
}

__device__ __forceinline__ float row_rstd(const float* ssq, int row, int fq) {
    const f32x4 p = *(const f32x4*)(ssq + (size_t)row * 16 + 4 * fq);
    float s = (p[0] + p[1]) + (p[2] + p[3]);
    s += __shfl_xor(s, 16); s += __shfl_xor(s, 32);
    return __builtin_amdgcn_rsqf(s * (1.0f / 1024.0f) + 1e-6f);
}
__device__ __forceinline__ float silu_f(float g) { return g * __builtin_amdgcn_rcpf(1.0f + __builtin_amdgcn_exp2f(g * -1.44269504089f)); }
__device__ __forceinline__ float sigm_f(float g) { return __builtin_amdgcn_rcpf(1.0f + __builtin_amdgcn_exp2f(g * -1.44269504089f)); }

struct EpiSwiGLU {
    static constexpr bool PERM = true, AFTER_DRAIN = false;
    bf16_t* O; int ldo; const float* ssq;
    __device__ __forceinline__ void operator()(const f32x4 (&acc)[2][2][4][2], const Unit& u, int wr, int wc, int fr, int fq) const {
        const int row0 = u.pm * BM + wr * 64 + fr, col0 = u.pn * HALF + wc * 32 + 8 * fq;
#pragma unroll
        for (int ai = 0; ai < 2; ++ai)
#pragma unroll
            for (int m = 0; m < 4; ++m) {
                const int row = row0 + ai * HALF + m * 16;
                const float rs = row_rstd(ssq, row, fq);
                const f32x4 g0 = acc[ai][0][m][0] * rs, g1 = acc[ai][0][m][1] * rs, u0 = acc[ai][1][m][0] * rs, u1 = acc[ai][1][m][1] * rs;
                u32x4 w;
                w.x = cvt_pk_bf16(silu_f(g0[0]) * u0[0], silu_f(g0[1]) * u0[1]); w.y = cvt_pk_bf16(silu_f(g0[2]) * u0[2], silu_f(g0[3]) * u0[3]);
                w.z = cvt_pk_bf16(silu_f(g1[0]) * u1[0], silu_f(g1[1]) * u1[1]); w.w = cvt_pk_bf16(silu_f(g1[2]) * u1[2], silu_f(g1[3]) * u1[3]);
                *(u32x4*)(O + (size_t)row * ldo + col0) = w;
            }
    }
};

struct EpiRes {
    static constexpr bool PERM = true, AFTER_DRAIN = false;
    const float* base; float* out; bf16_t* xb; float* ssq; float w;
    __device__ __forceinline__ void operator()(const f32x4 (&acc)[2][2][4][2], const Unit& u, int wr, int wc, int fr, int fq) const {
        const int row0 = u.pm * BM + wr * 64 + fr, col0 = u.pn * BM + wc * 32 + 8 * fq;
#pragma unroll
        for (int ai = 0; ai < 2; ++ai)
#pragma unroll
            for (int m = 0; m < 4; ++m) {
                const int row = row0 + ai * HALF + m * 16; float q = 0.f;
#pragma unroll
                for (int bj = 0; bj < 2; ++bj) {
                    const size_t off = (size_t)row * 1024 + col0 + bj * HALF;
                    const f32x4 b0 = *(const f32x4*)(base + off), b1 = *(const f32x4*)(base + off + 4);
                    const f32x4 v0 = b0 + acc[ai][bj][m][0] * w, v1 = b1 + acc[ai][bj][m][1] * w;
                    *(f32x4*)(out + off) = v0; *(f32x4*)(out + off + 4) = v1;
                    u32x4 pk; pk.x = cvt_pk_bf16(v0[0], v0[1]); pk.y = cvt_pk_bf16(v0[2], v0[3]); pk.z = cvt_pk_bf16(v1[0], v1[1]); pk.w = cvt_pk_bf16(v1[2], v1[3]);
                    *(u32x4*)(xb + off) = pk;
                    q += (v0[0] * v0[0] + v0[1] * v0[1]) + (v0[2] * v0[2] + v0[3] * v0[3]) + (v1[0] * v1[0] + v1[1] * v1[1]) + (v1[2] * v1[2] + v1[3] * v1[3]);
                }
                q += __shfl_xor(q, 16); q += __shfl_xor(q, 32);
                if (fq == 0) ssq[(size_t)row * 16 + u.pn * 4 + wc] = q;
                if (m & 1) asm volatile("" ::: "memory");
            }
    }
};

struct EpiWin {
    static constexpr bool PERM = true, AFTER_DRAIN = false;
    bf16_t* Z; int ldz; const float* ssq;
    __device__ __forceinline__ void operator()(const f32x4 (&acc)[2][2][4][2], const Unit& u, int wr, int wc, int fr, int fq) const {
        const int row0 = u.pm * BM + wr * 64 + fr, cw = wc * 32 + 8 * fq;
#pragma unroll
        for (int ai = 0; ai < 2; ++ai)
#pragma unroll
            for (int m = 0; m < 4; ++m) {
                const int row = row0 + ai * HALF + m * 16;
                const float rs = row_rstd(ssq, row, fq);
                bf16_t* zr = Z + (size_t)row * ldz;
                if (u.pn >= 3 && u.pn < 6) {
                    const f32x4 a0 = acc[ai][0][m][0] * rs, a1 = acc[ai][0][m][1] * rs, g0 = acc[ai][1][m][0] * rs, g1 = acc[ai][1][m][1] * rs;
                    u32x4 pk;
                    pk.x = cvt_pk_bf16(a0[0] * sigm_f(g0[0]), a0[1] * sigm_f(g0[1])); pk.y = cvt_pk_bf16(a0[2] * sigm_f(g0[2]), a0[3] * sigm_f(g0[3]));
                    pk.z = cvt_pk_bf16(a1[0] * sigm_f(g1[0]), a1[1] * sigm_f(g1[1])); pk.w = cvt_pk_bf16(a1[2] * sigm_f(g1[2]), a1[3] * sigm_f(g1[3]));
                    *(u32x4*)(zr + 768 + 128 * (u.pn - 3) + cw) = pk;
                } else {
                    const int cbase = (u.pn < 3) ? 256 * u.pn : 1152;
#pragma unroll
                    for (int bj = 0; bj < 2; ++bj) {
                        f32x4 v0 = acc[ai][bj][m][0] * rs, v1 = acc[ai][bj][m][1] * rs;
                        if (u.pn < 3) { const f32x2 a = gelu_pk((f32x2){v0[0], v0[1]}), b = gelu_pk((f32x2){v0[2], v0[3]}), c = gelu_pk((f32x2){v1[0], v1[1]}), d = gelu_pk((f32x2){v1[2], v1[3]});
                            v0 = (f32x4){a.x, a.y, b.x, b.y}; v1 = (f32x4){c.x, c.y, d.x, d.y}; }
                        u32x4 pk; pk.x = cvt_pk_bf16(v0[0], v0[1]); pk.y = cvt_pk_bf16(v0[2], v0[3]); pk.z = cvt_pk_bf16(v1[0], v1[1]); pk.w = cvt_pk_bf16(v1[2], v1[3]);
                        *(u32x4*)(zr + cbase + bj * HALF + cw) = pk;
                    }
                }
            }
    }
};

template <class Epi, class Sched, bool ALIGN_EPI = false, bool SP2 = false>
__device__ __forceinline__ void gemm_phase(PG8_LAS unsigned char* lds, const Gemm g, const Sched& S, const Epi& E) {
    int tid = threadIdx.x; asm volatile("" : "+v"(tid));
    const int wid = __builtin_amdgcn_readfirstlane(tid >> 6), lane = tid & 63, wr = wid >> 2, wc = wid & 3, fr = lane & 15, fq = lane >> 4;
    const int K = g.K, nt = K / BK;
    unsigned voffA[2], voffB[2];
#pragma unroll
    for (int i = 0; i < 2; ++i) { int R, C; stage_rc(tid * 16 + i * 8192, R, C); const int Rb = Epi::PERM ? ((R & ~31) + perm32(R & 31)) : R;
        voffA[i] = (unsigned)(R * K + C) * 2u; voffB[i] = (unsigned)(Rb * K + C) * 2u; }
    const size_t kstep = (size_t)(BK * 2);
    const size_t hstep = (size_t)HALF * K * 2;
    const size_t tstep = 2 * hstep;
    const unsigned ldsw = (unsigned)wid * 1024u;
    const int aoff = lds_byte(wr * 64 + fr, fq * 8), boff = lds_byte(wc * 32 + fr, fq * 8);
#define PG8_SA(b, h) (((b) * 2 + (h)) * HTB)
#define PG8_SB(b, h) ((4 + (b) * 2 + (h)) * HTB)
#define PG8_STAGE(bufoff, gbase, voff) do { _Pragma("unroll") for (int _i = 0; _i < 2; ++_i) \
        __builtin_amdgcn_global_load_lds((const unsigned*)((const char*)(gbase) + (voff)[_i]), (PG8_LAS unsigned*)(lds + (bufoff) + ldsw + _i * 8192), 16, 0, 0); } while (0)
#define PG8_LDA(dst, b, h) do { _Pragma("unroll") for (int m = 0; m < 4; ++m) _Pragma("unroll") for (int k = 0; k < 2; ++k) dst[m][k] = *(const PG8_LAS bf16x8*)(lds + PG8_SA(b, h) + aoff + m * 2048 + k * 1024); } while (0)
#define PG8_LDB(dst, b, h) do { _Pragma("unroll") for (int n = 0; n < 2; ++n) _Pragma("unroll") for (int k = 0; k < 2; ++k) dst[n][k] = *(const PG8_LAS bf16x8*)(lds + PG8_SB(b, h) + boff + n * 2048 + k * 1024); } while (0)
#define PG8_MMA(ai, bj, At, Bt) do { __builtin_amdgcn_s_setprio(1); _Pragma("unroll") for (int m = 0; m < 4; ++m) _Pragma("unroll") for (int n = 0; n < 2; ++n) _Pragma("unroll") for (int k = 0; k < 2; ++k) \
        acc[ai][bj][m][n] = __builtin_amdgcn_mfma_f32_16x16x32_bf16(Bt[n][k], At[m][k], acc[ai][bj][m][n], 0, 0, 0); __builtin_amdgcn_s_setprio(0); } while (0)
#define PG8_WAIT_V(n) asm volatile("s_waitcnt vmcnt(" #n ")" ::: "memory")
#define PG8_WAIT_L(n) asm volatile("s_waitcnt lgkmcnt(" #n ")" ::: "memory")
#define PG8_BAR __builtin_amdgcn_s_barrier()
#define PG8_SCHED __builtin_amdgcn_sched_barrier(0)
    Unit cur, nxt; int ui = 0;
    if (!S.next(0, cur)) return;
    f32x4 acc[2][2][4][2];
#pragma unroll
    for (int a = 0; a < 2; ++a)
#pragma unroll
        for (int b = 0; b < 2; ++b)
#pragma unroll
            for (int m = 0; m < 4; ++m)
#pragma unroll
                for (int n = 0; n < 2; ++n) acc[a][b][m][n] = (f32x4){0.f, 0.f, 0.f, 0.f};
    bf16x8 At[4][2], B0[2][2], B1[2][2];
    const char* cA = (const char*)g.A + (size_t)cur.pm * tstep; const char* cB = (const char*)g.Bt + (size_t)cur.pn * tstep;
    S.a_ready(cur);
    if constexpr (SP2) {
        PG8_STAGE(PG8_SB(0, 0), cB, voffB); PG8_STAGE(PG8_SB(0, 1), cB + hstep, voffB); PG8_STAGE(PG8_SA(0, 0), cA, voffA); PG8_STAGE(PG8_SA(0, 1), cA + hstep, voffA);
        if (wr == 1) PG8_BAR;
        PG8_WAIT_V(2); PG8_BAR;
        PG8_STAGE(PG8_SB(1, 0), cB + kstep, voffB); PG8_STAGE(PG8_SA(1, 0), cA + kstep, voffA); PG8_STAGE(PG8_SB(1, 1), cB + hstep + kstep, voffB);
        PG8_WAIT_V(6); PG8_BAR;
    } else {
        PG8_STAGE(PG8_SB(0, 0), cB, voffB); PG8_STAGE(PG8_SA(0, 0), cA, voffA); PG8_STAGE(PG8_SB(0, 1), cB + hstep, voffB); PG8_STAGE(PG8_SA(0, 1), cA + hstep, voffA);
        if (wr == 1) PG8_BAR;
        PG8_WAIT_V(4); PG8_BAR;
        PG8_STAGE(PG8_SB(1, 0), cB + kstep, voffB); PG8_STAGE(PG8_SA(1, 0), cA + kstep, voffA); PG8_STAGE(PG8_SB(1, 1), cB + hstep + kstep, voffB);
        PG8_WAIT_V(6); PG8_BAR;
    }
    for (;;) {
        const bool has_next = S.next(ui + 1, nxt);
        const char* nA = has_next ? (const char*)g.A + (size_t)nxt.pm * tstep : cA; const char* nB = has_next ? (const char*)g.Bt + (size_t)nxt.pn * tstep : cB;
        for (int t = 0; t < nt; t += 2) {
            const bool last = (t == nt - 2);
            const char* a1 = cA + (size_t)(t + 1) * kstep;
            const char* a2 = last ? nA : cA + (size_t)(t + 2) * kstep; const char* b2 = last ? nB : cB + (size_t)(t + 2) * kstep;
            const char* a3 = a2 + kstep; const char* b3 = b2 + kstep;
            if (last && has_next) S.a_ready(nxt);
            if constexpr (SP2) {
            PG8_LDB(B0, 0, 0); PG8_LDB(B1, 0, 1); PG8_SCHED; PG8_LDA(At, 0, 0); PG8_STAGE(PG8_SA(1, 1), a1 + hstep, voffA);
            PG8_WAIT_V(8); PG8_WAIT_L(0); PG8_BAR; PG8_MMA(0, 0, At, B0); PG8_MMA(0, 1, At, B1); PG8_BAR; PG8_SCHED;
            PG8_LDA(At, 0, 1); PG8_STAGE(PG8_SB(0, 0), b2, voffB); PG8_STAGE(PG8_SB(0, 1), b2 + hstep, voffB); PG8_STAGE(PG8_SA(0, 0), a2, voffA);
            PG8_WAIT_V(8); PG8_WAIT_L(0); PG8_BAR; PG8_MMA(1, 0, At, B0); PG8_MMA(1, 1, At, B1); PG8_BAR; PG8_SCHED;
            PG8_LDB(B0, 1, 0); PG8_LDB(B1, 1, 1); PG8_SCHED; PG8_LDA(At, 1, 0); PG8_STAGE(PG8_SA(0, 1), a2 + hstep, voffA);
            PG8_WAIT_V(8); PG8_WAIT_L(0); PG8_BAR; PG8_MMA(0, 0, At, B0); PG8_MMA(0, 1, At, B1); PG8_BAR; PG8_SCHED;
            PG8_LDA(At, 1, 1); PG8_STAGE(PG8_SB(1, 0), b3, voffB); PG8_STAGE(PG8_SB(1, 1), b3 + hstep, voffB); PG8_STAGE(PG8_SA(1, 0), a3, voffA);
            PG8_WAIT_V(8); PG8_WAIT_L(0); PG8_BAR; PG8_MMA(1, 0, At, B0); PG8_MMA(1, 1, At, B1); PG8_BAR; PG8_SCHED;
            } else {
            PG8_LDB(B0, 0, 0); PG8_SCHED; PG8_LDA(At, 0, 0); PG8_STAGE(PG8_SA(1, 1), a1 + hstep, voffA);
            PG8_WAIT_L(8); PG8_BAR; PG8_WAIT_L(0); PG8_MMA(0, 0, At, B0); PG8_BAR; PG8_SCHED;
            PG8_LDB(B1, 0, 1); PG8_STAGE(PG8_SB(0, 0), b2, voffB);
            PG8_BAR; PG8_WAIT_L(0); PG8_MMA(0, 1, At, B1); PG8_BAR;
            PG8_LDA(At, 0, 1); PG8_STAGE(PG8_SA(0, 0), a2, voffA);
            PG8_BAR; PG8_WAIT_L(0); PG8_MMA(1, 0, At, B0); PG8_BAR; PG8_SCHED;
            PG8_STAGE(PG8_SB(0, 1), b2 + hstep, voffB);
            PG8_WAIT_V(6); PG8_BAR; PG8_MMA(1, 1, At, B1); PG8_BAR;
            PG8_LDB(B0, 1, 0); PG8_SCHED; PG8_LDA(At, 1, 0); PG8_STAGE(PG8_SA(0, 1), a2 + hstep, voffA);
            PG8_WAIT_L(8); PG8_BAR; PG8_WAIT_L(0); PG8_MMA(0, 0, At, B0); PG8_BAR; PG8_SCHED;
            PG8_LDB(B1, 1, 1); PG8_STAGE(PG8_SB(1, 0), b3, voffB);
            PG8_BAR; PG8_WAIT_L(0); PG8_MMA(0, 1, At, B1); PG8_BAR;
            PG8_LDA(At, 1, 1); PG8_STAGE(PG8_SA(1, 0), a3, voffA);
            PG8_BAR; PG8_WAIT_L(0); PG8_MMA(1, 0, At, B0); PG8_BAR; PG8_SCHED;
            PG8_STAGE(PG8_SB(1, 1), b3 + hstep, voffB);
            PG8_WAIT_V(6); PG8_BAR; PG8_MMA(1, 1, At, B1); PG8_BAR;
            }
        }
        if constexpr (ALIGN_EPI) { if (wr == 0) PG8_BAR; }
        if constexpr (!Epi::AFTER_DRAIN) { E(acc, cur, wr, wc, fr, fq); S.done(cur); }
        if (!has_next) break;
#pragma unroll
        for (int a = 0; a < 2; ++a)
#pragma unroll
            for (int b = 0; b < 2; ++b)
#pragma unroll
                for (int m = 0; m < 4; ++m)
#pragma unroll
                    for (int n = 0; n < 2; ++n) acc[a][b][m][n] = (f32x4){0.f, 0.f, 0.f, 0.f};
        cur = nxt; cA = nA; cB = nB; ++ui;
        if constexpr (ALIGN_EPI) { if (wr == 1) PG8_BAR; }
    }
    PG8_WAIT_V(0);
    if constexpr (!ALIGN_EPI) { if (wr == 0) PG8_BAR; }
    PG8_BAR;
    if constexpr (Epi::AFTER_DRAIN) { E.fused(acc, cur, wr, wc, fr, fq, lds, wid, lane); S.done(cur); }
#undef PG8_SA
#undef PG8_SB
#undef PG8_STAGE
#undef PG8_LDA
#undef PG8_LDB
#undef PG8_MMA
#undef PG8_WAIT_V
#undef PG8_WAIT_L
#undef PG8_BAR
#undef PG8_SCHED
}
}

#ifndef MK_PER_PHASE
#define MK_PER_PHASE 0
#endif
#ifndef MK_PROBE
#define MK_PROBE 0
#endif
#define LAS __attribute__((address_space(3)))
using pg8::bf16_t; using pg8::f32x4; using pg8::u32x4; using pg8::bf16x8;
typedef unsigned u32x2 __attribute__((ext_vector_type(2)));

constexpr int M = 16384, SEQ = 4096, D = 1024, FF = 2816, DIN = 1792, NLAYER = 2;
constexpr int ZLD = 1408;
constexpr float EPS = 1e-6f;
constexpr int NPHASE = 16;
constexpr size_t MiB = 1u << 20;
constexpr size_t WS_SSQ = 1 * MiB, WS_W = 2 * MiB, WS_XB = 80 * MiB, WS_H = 112 * MiB, WS_Z = 112 * MiB, WS_Y = 156 * MiB;
constexpr size_t W_GU1 = 0, W_D1 = 11534336, W_IN = 17301504, W_OUT = 20971520, W_GU2 = 23068672, W_D2 = 34603008, W_LAYER = 40370176;
static_assert(WS_W + 2 * W_LAYER <= WS_XB && WS_Z + (size_t)M * ZLD * 2 <= WS_Y && WS_Y + (size_t)M * D * 2 <= WS_H + (size_t)M * FF * 2 && WS_H + (size_t)M * FF * 2 <= 256 * MiB, "ws map");
constexpr int LDS_BYTES = 147456;

__device__ __forceinline__ unsigned f2bf(float f) { unsigned u = __builtin_bit_cast(unsigned, f); return (u + 0x7fffu + ((u >> 16) & 1u)) >> 16; }
__device__ __forceinline__ unsigned pk2(float lo, float hi) { return f2bf(lo) | (f2bf(hi) << 16); }
__device__ __forceinline__ float bf_lo(unsigned w) { return __uint_as_float(w << 16); }
__device__ __forceinline__ float bf_hi(unsigned w) { return __uint_as_float(w & 0xffff0000u); }
__device__ __forceinline__ float wave_sum(float v) {
#pragma unroll
    for (int o = 1; o < 64; o <<= 1) v += __shfl_xor(v, o);
    return v;
}
__device__ __forceinline__ void ld6(const bf16_t* p, float (&v)[6]) {
    const unsigned* q = (const unsigned*)p; const unsigned a = q[0], b = q[1], c = q[2];
    v[0] = bf_lo(a); v[1] = bf_hi(a); v[2] = bf_lo(b); v[3] = bf_hi(b); v[4] = bf_lo(c); v[5] = bf_hi(c);
}

__device__ __forceinline__ int dst_row(int mode, int c) {
    if (mode == 0) return c;
    if (mode == 1) return 256 * (c >> 7) + (c & 127);
    if (mode == 2) return 256 * (c >> 7) + 128 + (c & 127);
    if (c < 768 || c >= 1536) return c;
    if (c < 1152) { const int j = c - 768; return 768 + 256 * (j >> 7) + (j & 127); }
    { const int j = c - 1152; return 768 + 256 * (j >> 7) + 128 + (j & 127); }
}
__device__ __forceinline__ void p0_transpose_item(const float* W, int K, int N, bf16_t* WT, int mode, const float* gk, LAS float* scr, int item, int lane) {
    const int nblk = N / 64, kb = item / nblk, nb = item % nblk, k0 = 64 * kb, n0 = 64 * nb;
    const float* src = W + (size_t)k0 * N + n0;
    float v[64];
#pragma unroll
    for (int i = 0; i < 64; ++i) v[i] = src[(size_t)i * N + lane];
#pragma unroll
    for (int i = 0; i < 64; ++i) scr[i * 65 + lane] = v[i];
    asm volatile("s_waitcnt lgkmcnt(0)" ::: "memory");
    const int c = lane & 7; const int dr0 = dst_row(mode, n0);
    f32x4 g0 = (f32x4){1.f, 1.f, 1.f, 1.f}, g1 = g0;
    if (gk) { g0 = *(const f32x4*)(gk + k0 + 8 * c); g1 = *(const f32x4*)(gk + k0 + 8 * c + 4); }
#pragma unroll
    for (int j = 0; j < 8; ++j) { const int n = (lane >> 3) + 8 * j; const LAS float* s = scr + (8 * c) * 65 + n;
        u32x4 o; o.x = pk2(s[0 * 65] * g0[0], s[1 * 65] * g0[1]); o.y = pk2(s[2 * 65] * g0[2], s[3 * 65] * g0[3]); o.z = pk2(s[4 * 65] * g1[0], s[5 * 65] * g1[1]); o.w = pk2(s[6 * 65] * g1[2], s[7 * 65] * g1[3]);
        *(u32x4*)(WT + (size_t)(dr0 + n) * K + k0 + 8 * c) = o; }
    asm volatile("s_waitcnt lgkmcnt(0)" ::: "memory");
}

#define XB_TMO      128
#define XB_XCNT(j)  (256  + 64 * (j))
#define XB_XSUB(j)  (1280 + 64 * (j))
#define XB_XGEN(j)  (2304 + 64 * (j))
#define XB_TOP      3328
#define XB_TOPGEN   3392
#define XCD_BAR_WORDS 3456
#define XB_SPIN_CAP (1u << 18)

__device__ __forceinline__ unsigned xb_ld(unsigned* p)              { return __hip_atomic_load(p, __ATOMIC_RELAXED, __HIP_MEMORY_SCOPE_AGENT); }
__device__ __forceinline__ unsigned xb_add(unsigned* p, unsigned v) { return __hip_atomic_fetch_add(p, v, __ATOMIC_RELAXED, __HIP_MEMORY_SCOPE_AGENT); }
__device__ __forceinline__ unsigned xb_xcc_id() { return (unsigned)__builtin_amdgcn_s_getreg((3 << 11) | 20) & 0xFu; }
#define XB_SPIN(cond, bar) do { unsigned _sp = 0; while (cond) { __builtin_amdgcn_s_sleep(1); \
    if ((++_sp & 255u) == 0u) { if (xb_ld(&(bar)[XB_TMO])) break; if (_sp > XB_SPIN_CAP) { atomicAdd(&(bar)[XB_TMO], 1u); break; } } } } while (0)

struct XcdBarrier {
    unsigned* bar; unsigned x;
    volatile LAS unsigned* st;
};

__device__ __forceinline__ XcdBarrier xcd_barrier_post(unsigned* bar, volatile LAS unsigned* st) {
    XcdBarrier b; b.bar = bar; b.x = xb_xcc_id(); b.st = st;
    if (threadIdx.x == 0) (void)xb_add(&bar[XB_XCNT(b.x)], 1u);
    return b;
}
__device__ __forceinline__ void xcd_barrier_complete(unsigned* bar, unsigned x, unsigned& nloc, unsigned& nx) {
    const unsigned G = gridDim.x * gridDim.y * gridDim.z;
    unsigned sum, cnt, mine, sp = 0u;
    for (;;) {
        sum = 0u; cnt = 0u; mine = 0u;
#pragma unroll
        for (unsigned j = 0; j < 16; ++j) { const unsigned c = xb_ld(&bar[XB_XCNT(j)]); sum += c; cnt += (c > 0u) ? 1u : 0u; mine = (j == x) ? c : mine; }
        if (sum == G) break;
        __builtin_amdgcn_s_sleep(1);
        if ((++sp & 255u) == 0u) { if (xb_ld(&bar[XB_TMO])) break; if (sp > XB_SPIN_CAP) { atomicAdd(&bar[XB_TMO], 1u); break; } }
    }
    nloc = mine > 0u ? mine : 1u; nx = cnt > 0u ? cnt : 1u;
}

__device__ __forceinline__ void xcd_barrier(const XcdBarrier& b) {
    asm volatile("s_waitcnt vmcnt(0)" ::: "memory");
    __syncthreads();
    if (threadIdx.x == 0) {
        unsigned* bar = b.bar;
        __builtin_amdgcn_s_waitcnt(0);
        unsigned nloc = b.st[0], nx = b.st[1];
        if (nloc == 0u) { xcd_barrier_complete(bar, b.x, nloc, nx); b.st[0] = nloc; b.st[1] = nx; }
        const unsigned old = xb_add(&bar[XB_XSUB(b.x)], 1u);
        const unsigned gen = old / nloc;
        if (old + 1u == (gen + 1u) * nloc) {
            __builtin_amdgcn_fence(__ATOMIC_RELEASE, "agent");
            asm volatile("s_waitcnt vmcnt(0)" ::: "memory");
            const unsigned og = xb_add(&bar[XB_TOP], 1u);
            const unsigned tg = og / nx;
            if (og + 1u == (tg + 1u) * nx) xb_add(&bar[XB_TOPGEN], 1u);
            else XB_SPIN(xb_ld(&bar[XB_TOPGEN]) == tg, bar);
            __builtin_amdgcn_fence(__ATOMIC_ACQUIRE, "agent");
            xb_add(&bar[XB_XGEN(b.x)], 1u);
            asm volatile("s_waitcnt vmcnt(0)" ::: "memory");
        } else {
            XB_SPIN(xb_ld(&bar[XB_XGEN(b.x)]) == gen, bar);
            __builtin_amdgcn_fence(__ATOMIC_ACQUIRE, "agent");
            asm volatile("s_waitcnt vmcnt(0)" ::: "memory");
        }
    }
    __syncthreads();
}

struct Args { const float* in[23]; float* out; unsigned char* ws; int ph_lo, ph_hi; };

__device__ __forceinline__ void prologue_phase(const Args& args, LAS unsigned char* lds, int lane, int wave, int G, int bx) {
    unsigned char* ws = args.ws;
    LAS float* scr = (LAS float*)(lds + wave * 16640);
    const int gw = bx * 8 + wave, NGW = G * 8;
    constexpr int I_G = (D / 64) * (FF / 64), I_D = (FF / 64) * (D / 64), I_IN = (D / 64) * (DIN / 64), I_OUT = (D / 64) * (D / 64);
    constexpr int I_LAYER = 4 * I_G + 2 * I_D + I_IN + I_OUT;
#pragma unroll 1
    for (int it = gw; it < NLAYER * I_LAYER; it += NGW) {
        const int l = it / I_LAYER; int r = it % I_LAYER;
        unsigned char* wl = ws + WS_W + (size_t)l * W_LAYER;
        const size_t oG = (size_t)l * D * FF, oD = (size_t)l * FF * D;
        const float* W; const float* gk; bf16_t* WT; int K, N, mode;
        if (r < I_G) { W = args.in[2] + oG; K = D; N = FF; WT = (bf16_t*)(wl + W_GU1); mode = 1; gk = args.in[1] + l * D; }
        else if ((r -= I_G) < I_G) { W = args.in[3] + oG; K = D; N = FF; WT = (bf16_t*)(wl + W_GU1); mode = 2; gk = args.in[1] + l * D; }
        else if ((r -= I_G) < I_D) { W = args.in[4] + oD; K = FF; N = D; WT = (bf16_t*)(wl + W_D1); mode = 0; gk = nullptr; }
        else if ((r -= I_D) < I_IN) { W = args.in[6] + (size_t)l * D * DIN; K = D; N = DIN; WT = (bf16_t*)(wl + W_IN); mode = 3; gk = args.in[5] + l * D; }
        else if ((r -= I_IN) < I_OUT) { W = args.in[17] + (size_t)l * D * D; K = D; N = D; WT = (bf16_t*)(wl + W_OUT); mode = 0; gk = nullptr; }
        else if ((r -= I_OUT) < I_G) { W = args.in[19] + oG; K = D; N = FF; WT = (bf16_t*)(wl + W_GU2); mode = 1; gk = args.in[18] + l * D; }
        else if ((r -= I_G) < I_G) { W = args.in[20] + oG; K = D; N = FF; WT = (bf16_t*)(wl + W_GU2); mode = 2; gk = args.in[18] + l * D; }
        else { r -= I_G; W = args.in[21] + oD; K = FF; N = D; WT = (bf16_t*)(wl + W_D2); mode = 0; gk = nullptr; }
        p0_transpose_item(W, K, N, WT, mode, gk, scr, r, lane);
    }
    const float* x = args.in[0]; bf16_t* xb = (bf16_t*)(ws + WS_XB); float* ssq = (float*)(ws + WS_SSQ);
#pragma unroll 1
    for (int m = 2 * gw; m < M; m += 2 * NGW) {
        const f32x4* xr = (const f32x4*)(x + (size_t)m * D) + lane;
        f32x4 v[8]; float s0 = 0.f, s1 = 0.f;
#pragma unroll
        for (int j = 0; j < 8; ++j) v[j] = xr[64 * j];
#pragma unroll
        for (int j = 0; j < 4; ++j) { s0 += (v[j][0] * v[j][0] + v[j][1] * v[j][1]) + (v[j][2] * v[j][2] + v[j][3] * v[j][3]);
                                      s1 += (v[j + 4][0] * v[j + 4][0] + v[j + 4][1] * v[j + 4][1]) + (v[j + 4][2] * v[j + 4][2] + v[j + 4][3] * v[j + 4][3]); }
        s0 = wave_sum(s0); s1 = wave_sum(s1);
        u32x2* o8 = (u32x2*)(xb + (size_t)m * D) + lane;
#pragma unroll
        for (int j = 0; j < 8; ++j) { u32x2 o; o.x = pk2(v[j][0], v[j][1]); o.y = pk2(v[j][2], v[j][3]); o8[64 * j] = o; }
        if (lane < 32) ssq[(size_t)m * 16 + lane] = (lane == 0) ? s0 : ((lane == 16) ? s1 : 0.f);
    }
}

__device__ __forceinline__ void final_phase(const Args& args, int lane, int wave, int G, int bx) {
    const float* ssq = (const float*)(args.ws + WS_SSQ); const float* g = args.in[22]; float* out = args.out;
    const int gw = bx * 8 + wave, NGW = G * 8;
    f32x4 gv[4];
#pragma unroll
    for (int j = 0; j < 4; ++j) gv[j] = ((const f32x4*)g)[lane + 64 * j];
    for (int m = gw; m < M; m += NGW) {
        float s = (lane < 16) ? ssq[(size_t)m * 16 + lane] : 0.f;
        s = wave_sum(s);
        const float rs = 1.0f / sqrtf(s * (1.0f / D) + EPS);
        f32x4* xr = (f32x4*)(out + (size_t)m * D) + lane;
#pragma unroll
        for (int j = 0; j < 4; ++j) { f32x4 v = xr[64 * j]; v = v * rs * gv[j]; xr[64 * j] = v; }
    }
}

constexpr int VT_LD = 136, PW_LD = 72, PS_LD = 264, GS_LD = 384;
constexpr int L_VT = 0, L_PS = 52224, L_PW = L_PS + 79 * PS_LD * 2, L_END1 = L_PW + 4 * 64 * PW_LD * 2;
constexpr int L_GS = 0, L_CW = 94 * GS_LD * 2, L_END2 = L_CW + 31 * 384 * 4;
static_assert(L_END1 <= LDS_BYTES - 16 && L_END2 <= LDS_BYTES - 16, "lds map");
typedef float f32x2_t __attribute__((ext_vector_type(2)));

__device__ __forceinline__ void mixer_phase(LAS unsigned char* lds, const bf16_t* Z, bf16_t* Y,
        const float* sgu_g, const float* sgu_b, const float* wsp, const float* bsp,
        const float* cw, const float* cbias, const float* cln_g, const float* cln_b,
        const float* pw, const float* ps, int tid, int lane, int wave, int G, int bx) {
    LAS bf16_t* VT = (LAS bf16_t*)(lds + L_VT);
    LAS bf16_t* PS = (LAS bf16_t*)(lds + L_PS);
    LAS bf16_t* PW = (LAS bf16_t*)(lds + L_PW);
    LAS bf16_t* GS = (LAS bf16_t*)(lds + L_GS);
    LAS float* CW = (LAS float*)(lds + L_CW);
    const int fr = lane & 15, kq = lane >> 4;
#pragma unroll 1
    for (int unit = bx; unit < 256; unit += G) {
        const int chunk = unit >> 1, half = unit & 1;
        const int cb0 = chunk * 128, t0 = cb0 + 64 * half, tpos0 = t0 & (SEQ - 1);
        __syncthreads();
        for (int i = tid; i < 4 * 64 * 64; i += 512) { const int g = i >> 12, c = (i >> 6) & 63, d = i & 63; PW[(g * 64 + d) * PW_LD + c] = (bf16_t)f2bf(pw[i]); }
        for (int i = tid; i < 79 * 32; i += 512) { const int r = i >> 5, c16 = i & 31;
            u32x4 v = (u32x4){0u, 0u, 0u, 0u};
            if (tpos0 - 15 + r >= 0) v = *(const u32x4*)(Z + (size_t)(t0 - 15 + r) * ZLD + 1152 + 8 * c16);
            *(LAS u32x4*)(PS + r * PS_LD + 8 * c16) = v; }
        {
            float gg[6], bb[6];
#pragma unroll
            for (int k = 0; k < 6; ++k) { gg[k] = sgu_g[6 * lane + k]; bb[k] = sgu_b[6 * lane + k]; }
            unsigned raw[16][3];
#pragma unroll
            for (int qi = 0; qi < 16; ++qi) { const unsigned* q = (const unsigned*)(Z + (size_t)(cb0 + 16 * wave + qi) * ZLD + 384 + 6 * lane); raw[qi][0] = q[0]; raw[qi][1] = q[1]; raw[qi][2] = q[2]; }
#pragma unroll
            for (int qi = 0; qi < 16; ++qi) {
                const int q = 16 * wave + qi;
                float v[6] = {bf_lo(raw[qi][0]), bf_hi(raw[qi][0]), bf_lo(raw[qi][1]), bf_hi(raw[qi][1]), bf_lo(raw[qi][2]), bf_hi(raw[qi][2])};
                const float s = ((v[0] + v[1]) + (v[2] + v[3])) + (v[4] + v[5]);
                const float mean = wave_sum(s) * (1.0f / 384.0f);
                float s2 = 0.f;
#pragma unroll
                for (int k = 0; k < 6; ++k) { v[k] -= mean; s2 += v[k] * v[k]; }
                const float rstd = 1.0f / sqrtf(wave_sum(s2) * (1.0f / 384.0f) + EPS);
                if ((lane >> 5) == half) {
#pragma unroll
                    for (int k = 0; k < 6; ++k) VT[(6 * (lane & 31) + k) * VT_LD + q] = (bf16_t)f2bf(v[k] * rstd * gg[k] + bb[k]);
                }
            }
        }
        __syncthreads();
        {
            const int p = 16 * wave + fr;
            const int nks = (wave >> 1) + 1;
            const size_t trow = (size_t)(cb0 + p);
#pragma unroll
            for (int hl = 0; hl < 3; ++hl) {
                const int h = 3 * half + hl;
                f32x4 w0[4], w1[4];
#pragma unroll
                for (int ks = 0; ks < 4; ++ks) if (ks < nks) { const float* wp = wsp + ((size_t)h * 128 + p) * 128 + 32 * ks + 8 * kq; w0[ks] = *(const f32x4*)wp; w1[ks] = *(const f32x4*)(wp + 4); }
                u32x2 uu[4];
#pragma unroll
                for (int ct = 0; ct < 4; ++ct) uu[ct] = *(const u32x2*)(Z + trow * ZLD + h * 64 + 16 * ct + 4 * kq);
                const float bs = bsp[h * 128 + p];
                f32x4 accd[4];
#pragma unroll
                for (int ct = 0; ct < 4; ++ct) accd[ct] = (f32x4){0.f, 0.f, 0.f, 0.f};
#pragma unroll
                for (int ks = 0; ks < 4; ++ks) if (ks < nks) {
                    const int q0 = 32 * ks + 8 * kq;
                    u32x4 bw;
                    bw.x = pk2(q0 + 0 <= p ? w0[ks][0] : 0.f, q0 + 1 <= p ? w0[ks][1] : 0.f); bw.y = pk2(q0 + 2 <= p ? w0[ks][2] : 0.f, q0 + 3 <= p ? w0[ks][3] : 0.f);
                    bw.z = pk2(q0 + 4 <= p ? w1[ks][0] : 0.f, q0 + 5 <= p ? w1[ks][1] : 0.f); bw.w = pk2(q0 + 6 <= p ? w1[ks][2] : 0.f, q0 + 7 <= p ? w1[ks][3] : 0.f);
                    const bf16x8 bfrag = __builtin_bit_cast(bf16x8, bw);
#pragma unroll
                    for (int ct = 0; ct < 4; ++ct) {
                        const bf16x8 afrag = *(const LAS bf16x8*)(VT + (hl * 64 + 16 * ct + fr) * VT_LD + q0);
                        accd[ct] = __builtin_amdgcn_mfma_f32_16x16x32_bf16(afrag, bfrag, accd[ct], 0, 0, 0);
                    }
                }
#pragma unroll
                for (int ct = 0; ct < 4; ++ct) {
                    const int c0 = h * 64 + 16 * ct + 4 * kq;
                    u32x2 o;
                    o.x = pk2(bf_lo(uu[ct].x) * (accd[ct][0] + bs), bf_hi(uu[ct].x) * (accd[ct][1] + bs));
                    o.y = pk2(bf_lo(uu[ct].y) * (accd[ct][2] + bs), bf_hi(uu[ct].y) * (accd[ct][3] + bs));
                    *(u32x2*)(Y + trow * D + c0) = o;
                }
            }
        }
        {
            const int tl = 16 * (wave & 3) + fr, t = t0 + tl, tpos = tpos0 + tl;
#pragma unroll 1
            for (int gi = 0; gi < 2; ++gi) {
                const int g = 2 * (wave >> 2) + gi, win = 2 << g;
                const float inv = 1.0f / (float)((tpos + 1 < win) ? (tpos + 1) : win);
                f32x4 accd[4];
#pragma unroll
                for (int dt = 0; dt < 4; ++dt) accd[dt] = (f32x4){0.f, 0.f, 0.f, 0.f};
#pragma unroll
                for (int ks = 0; ks < 2; ++ks) {
                    const int c0 = g * 64 + 32 * ks + 8 * kq;
                    const LAS bf16_t* pp = PS + (15 + tl) * PS_LD + c0;
                    const u32x4 cur = *(const LAS u32x4*)pp;
                    float s[8] = {bf_lo(cur.x), bf_hi(cur.x), bf_lo(cur.y), bf_hi(cur.y), bf_lo(cur.z), bf_hi(cur.z), bf_lo(cur.w), bf_hi(cur.w)};
#pragma unroll 4
                    for (int i = 1; i < win; ++i) {
                        const u32x4 r = *(const LAS u32x4*)(pp - i * PS_LD);
                        s[0] += bf_lo(r.x); s[1] += bf_hi(r.x); s[2] += bf_lo(r.y); s[3] += bf_hi(r.y);
                        s[4] += bf_lo(r.z); s[5] += bf_hi(r.z); s[6] += bf_lo(r.w); s[7] += bf_hi(r.w);
                    }
                    u32x4 bw;
                    bw.x = pk2(s[0] * inv - bf_lo(cur.x), s[1] * inv - bf_hi(cur.x)); bw.y = pk2(s[2] * inv - bf_lo(cur.y), s[3] * inv - bf_hi(cur.y));
                    bw.z = pk2(s[4] * inv - bf_lo(cur.z), s[5] * inv - bf_hi(cur.z)); bw.w = pk2(s[6] * inv - bf_lo(cur.w), s[7] * inv - bf_hi(cur.w));
                    const bf16x8 bfrag = __builtin_bit_cast(bf16x8, bw);
#pragma unroll
                    for (int dt = 0; dt < 4; ++dt) {
                        const bf16x8 afrag = *(const LAS bf16x8*)(PW + (g * 64 + 16 * dt + fr) * PW_LD + 32 * ks + 8 * kq);
                        accd[dt] = __builtin_amdgcn_mfma_f32_16x16x32_bf16(afrag, bfrag, accd[dt], 0, 0, 0);
                    }
                }
#pragma unroll
                for (int dt = 0; dt < 4; ++dt) {
                    const int d0 = g * 64 + 16 * dt + 4 * kq;
                    const f32x4 sc = *(const f32x4*)(ps + d0);
                    u32x2 o; o.x = pk2(accd[dt][0] * sc[0], accd[dt][1] * sc[1]); o.y = pk2(accd[dt][2] * sc[2], accd[dt][3] * sc[3]);
                    *(u32x2*)(Y + (size_t)t * D + 768 + d0) = o;
                }
            }
        }
        __syncthreads();
        for (int i = tid; i < 31 * 384 / 4; i += 512) ((LAS f32x4*)CW)[i] = ((const f32x4*)cw)[i];
        for (int i = tid; i < 94 * 48; i += 512) { const int r = i / 48, c16 = i % 48;
            u32x4 v = (u32x4){0u, 0u, 0u, 0u};
            if (tpos0 - 30 + r >= 0) v = *(const u32x4*)(Z + (size_t)(t0 - 30 + r) * ZLD + 768 + 8 * c16);
            *(LAS u32x4*)(GS + r * GS_LD + 8 * c16) = v; }
        __syncthreads();
        {
            f32x2_t acc[8][3], wn[8][3];
            {
                const f32x2_t b0 = *(const f32x2_t*)(cbias + 6 * lane), b1 = *(const f32x2_t*)(cbias + 6 * lane + 2), b2 = *(const f32x2_t*)(cbias + 6 * lane + 4);
#pragma unroll
                for (int i = 0; i < 8; ++i) { acc[i][0] = b0; acc[i][1] = b1; acc[i][2] = b2; }
            }
            const LAS unsigned* gbase = (const LAS unsigned*)(GS + (8 * wave) * GS_LD + 6 * lane);
#pragma unroll
            for (int r = 0; r < 7; ++r) { const LAS unsigned* gp = gbase + r * (GS_LD / 2); const unsigned a = gp[0], b = gp[1], c = gp[2];
                wn[r][0] = (f32x2_t){bf_lo(a), bf_hi(a)}; wn[r][1] = (f32x2_t){bf_lo(b), bf_hi(b)}; wn[r][2] = (f32x2_t){bf_lo(c), bf_hi(c)}; }
#pragma unroll
            for (int j = 0; j < 31; ++j) {
                { const LAS unsigned* gp = gbase + (j + 7) * (GS_LD / 2); const unsigned a = gp[0], b = gp[1], c = gp[2]; const int sl = (j + 7) & 7;
                  wn[sl][0] = (f32x2_t){bf_lo(a), bf_hi(a)}; wn[sl][1] = (f32x2_t){bf_lo(b), bf_hi(b)}; wn[sl][2] = (f32x2_t){bf_lo(c), bf_hi(c)}; }
                const LAS f32x2_t* wp = (const LAS f32x2_t*)(CW + j * 384 + 6 * lane);
                const f32x2_t w0 = wp[0], w1 = wp[1], w2 = wp[2];
#pragma unroll
                for (int i = 0; i < 8; ++i) { const int sl = (j + i) & 7; acc[i][0] += w0 * wn[sl][0]; acc[i][1] += w1 * wn[sl][1]; acc[i][2] += w2 * wn[sl][2]; }
            }
            float lg[6], lb[6];
#pragma unroll
            for (int k = 0; k < 6; ++k) { lg[k] = cln_g[6 * lane + k]; lb[k] = cln_b[6 * lane + k]; }
#pragma unroll
            for (int i = 0; i < 8; ++i) {
                float a[6] = {acc[i][0].x, acc[i][0].y, acc[i][1].x, acc[i][1].y, acc[i][2].x, acc[i][2].y};
                const float s = ((a[0] + a[1]) + (a[2] + a[3])) + (a[4] + a[5]);
                const float mean = wave_sum(s) * (1.0f / 384.0f);
                float s2 = 0.f;
#pragma unroll
                for (int k = 0; k < 6; ++k) { a[k] -= mean; s2 += a[k] * a[k]; }
                const float rstd = 1.0f / sqrtf(wave_sum(s2) * (1.0f / 384.0f) + EPS);
                float y[6];
#pragma unroll
                for (int k = 0; k < 6; ++k) { const float v = a[k] * rstd * lg[k] + lb[k]; y[k] = v / (1.0f + __expf(-v)); }
                unsigned* yo = (unsigned*)(Y + (size_t)(t0 + 8 * wave + i) * D + 384 + 6 * lane);
                yo[0] = pk2(y[0], y[1]); yo[1] = pk2(y[2], y[3]); yo[2] = pk2(y[4], y[5]);
            }
        }
    }
}

__global__ void __launch_bounds__(512, 2) mk_fwd(Args args) {
    extern __shared__ __attribute__((aligned(16))) unsigned char lds_raw[];
    LAS unsigned char* lds = (LAS unsigned char*)lds_raw;
    const int tid = threadIdx.x, lane = tid & 63, wave = __builtin_amdgcn_readfirstlane(tid >> 6);
    const int G = gridDim.x, bx = blockIdx.x;
    unsigned* barw = (unsigned*)args.ws;
    volatile LAS unsigned* bst = (volatile LAS unsigned*)(lds + LDS_BYTES - 16);
    if (tid < 2) bst[tid] = 0u;
    if (bx == 0) for (int i = tid; i < XCD_BAR_WORDS; i += 512) __hip_atomic_store(barw + i, 0u, __ATOMIC_RELAXED, __HIP_MEMORY_SCOPE_AGENT);
    __syncthreads();
    if (args.ph_lo == 0) { prologue_phase(args, lds, lane, wave, G, bx);
#if MK_PROBE == 1
        __syncthreads(); prologue_phase(args, lds, lane, wave, G, bx);
#endif
        if (args.ph_hi > 1) cg::this_grid().sync(); }
    XcdBarrier xbar = xcd_barrier_post(barw, bst);
    const int plo = args.ph_lo < 1 ? 1 : args.ph_lo, phi = args.ph_hi > NPHASE - 1 ? NPHASE - 1 : args.ph_hi;
#pragma unroll 1
    for (int ph = plo; ph < phi; ++ph) {
        int tid_ = threadIdx.x; asm volatile("" : "+v"(tid_));
        const int lane_ = tid_ & 63, wave_ = __builtin_amdgcn_readfirstlane(tid_ >> 6);
        unsigned char* wsp_ = args.ws; asm volatile("" : "+s"(wsp_));
        bf16_t* XB = (bf16_t*)(wsp_ + WS_XB); bf16_t* HB = (bf16_t*)(wsp_ + WS_H); bf16_t* ZB = (bf16_t*)(wsp_ + WS_Z); bf16_t* YB = (bf16_t*)(wsp_ + WS_Y);
        float* SSQ = (float*)(wsp_ + WS_SSQ);
        const int l = (ph - 1) / 7, s = (ph - 1) % 7;
        unsigned char* wl = wsp_ + WS_W + (size_t)l * W_LAYER;
        if (s == 0 || s == 5) {
            pg8::Gemm g{XB, (const bf16_t*)(wl + (s == 0 ? W_GU1 : W_GU2)), M, 2 * FF, D};
            pg8::StaticOrder S; S.init(M, 2 * FF, G, bx);
            pg8::EpiSwiGLU E{HB, FF, SSQ};
            pg8::gemm_phase<pg8::EpiSwiGLU, pg8::StaticOrder, true, true>(lds, g, S, E);
#if MK_PROBE == 4
            __syncthreads(); pg8::gemm_phase<pg8::EpiSwiGLU, pg8::StaticOrder, true, true>(lds, g, S, E);
#endif
        } else if (s == 1 || s == 6 || s == 4) {
            pg8::Gemm g{s == 4 ? YB : HB, (const bf16_t*)(wl + (s == 1 ? W_D1 : (s == 6 ? W_D2 : W_OUT))), M, D, s == 4 ? D : FF};
            pg8::StaticOrder S; S.init(M, D, G, bx);
            pg8::EpiRes E{(l == 0 && s == 1) ? args.in[0] : args.out, args.out, XB, SSQ, s == 4 ? 1.0f : 0.5f};
            pg8::gemm_phase<pg8::EpiRes, pg8::StaticOrder, true, true>(lds, g, S, E);
        } else if (s == 2) {
            pg8::Gemm g{XB, (const bf16_t*)(wl + W_IN), M, DIN, D};
            pg8::StaticOrder S; S.init(M, DIN, G, bx);
            pg8::EpiWin E{ZB, ZLD, SSQ};
            pg8::gemm_phase<pg8::EpiWin, pg8::StaticOrder, true, true>(lds, g, S, E);
        } else {
            mixer_phase(lds, ZB, YB, args.in[7] + l * 384, args.in[8] + l * 384, args.in[9] + (size_t)l * 6 * 128 * 128, args.in[10] + l * 6 * 128,
                        args.in[11] + (size_t)l * 31 * 384, args.in[12] + l * 384, args.in[13] + l * 384, args.in[14] + l * 384,
                        args.in[15] + (size_t)l * 4 * 64 * 64, args.in[16] + l * 256, tid_, lane_, wave_, G, bx);
#if MK_PROBE == 2
            mixer_phase(lds, ZB, YB, args.in[7] + l * 384, args.in[8] + l * 384, args.in[9] + (size_t)l * 6 * 128 * 128, args.in[10] + l * 6 * 128,
                        args.in[11] + (size_t)l * 31 * 384, args.in[12] + l * 384, args.in[13] + l * 384, args.in[14] + l * 384,
                        args.in[15] + (size_t)l * 4 * 64 * 64, args.in[16] + l * 256, tid_, lane_, wave_, G, bx);
#endif
        }
        if (ph + 1 < args.ph_hi) { xcd_barrier(xbar);
#if MK_PROBE == 3
            xcd_barrier(xbar);
#endif
        }
    }
    if (args.ph_hi == NPHASE) final_phase(args, lane, wave, G, bx);
}

extern "C" void kernel_launch(void* const* d_in, const int* in_sizes, int n_in, void* d_out, int out_size, void* d_ws, size_t ws_size, hipStream_t stream) {
    static int grid = 0;
    if (grid == 0) {
        int dev = 0, cus = 0, per_cu = 0;
        hipGetDevice(&dev);
        hipDeviceGetAttribute(&cus, hipDeviceAttributeMultiprocessorCount, dev);
        if (hipFuncSetAttribute((const void*)mk_fwd, hipFuncAttributeMaxDynamicSharedMemorySize, LDS_BYTES) != hipSuccess) fprintf(stderr, "kernel_launch: hipFuncSetAttribute failed\n");
        if (hipOccupancyMaxActiveBlocksPerMultiprocessor(&per_cu, (const void*)mk_fwd, 512, LDS_BYTES) != hipSuccess || per_cu < 1) { fprintf(stderr, "kernel_launch: occupancy query says %d\n", per_cu); per_cu = 1; }
        (void)hipGetLastError();
        grid = cus * 1;
        if (grid <= 0) grid = 256;
    }
    Args a{};
    for (int i = 0; i < 23; ++i) a.in[i] = (const float*)d_in[i];
    a.out = (float*)d_out; a.ws = (unsigned char*)d_ws;
#if MK_PER_PHASE
    for (int ph = 0; ph < NPHASE; ++ph) { a.ph_lo = ph; a.ph_hi = ph + 1; hipLaunchKernelGGL(mk_fwd, dim3(grid), dim3(512), LDS_BYTES, stream, a); }
#else
    a.ph_lo = 0; a.ph_hi = NPHASE;
    void* kargs[] = {&a};
    const hipError_t e = hipLaunchCooperativeKernel((const void*)mk_fwd, dim3(grid), dim3(512), kargs, LDS_BYTES, stream);
    if (e != hipSuccess) fprintf(stderr, "kernel_launch: cooperative launch failed: %s (grid %d)\n", hipGetErrorString(e), grid);
#endif
}
```

```cpp
#include <hip/hip_runtime.h>
#include <hip/hip_cooperative_groups.h>
#include <cstdio>
#include <cstdint>
namespace cg = cooperative_groups;
namespace pg8 {
#define PG8_LAS __attribute__((address_space(3)))
typedef unsigned short bf16_t;
typedef short bf16x8 __attribute__((ext_vector_type(8)));
typedef float f32x4 __attribute__((ext_vector_type(4)));
typedef unsigned u32x4 __attribute__((ext_vector_type(4)));
constexpr int BM = 256, BK = 64, HALF = 128, HTB = HALF * BK * 2  , STAGE_BYTES = 8 * HTB, NXCD = 8, WGM = 8;

__host__ __device__ __forceinline__ int lds_byte(int r, int c) { const int st = (r >> 4) * 2 + (c >> 5), rr = r & 15, cc = c & 31, ob = rr * 64 + cc * 2; return st * 1024 + (ob ^ (((ob >> 9) & 1) << 5)); }
__host__ __device__ __forceinline__ void stage_rc(int b, int& R, int& C) { const int st = b / 1024, sb = b % 1024, swz = sb ^ (((sb >> 9) & 1) << 5); R = (st >> 1) * 16 + swz / 64; C = (st & 1) * 32 + (swz % 64) / 2; }
__host__ __device__ __forceinline__ int perm32(int rho) { const int n = rho >> 4, i = rho & 15; return 8 * (i >> 2) + 4 * n + (i & 3); }

struct Unit { int pm, pn; };
struct Gemm { const bf16_t* A; const bf16_t* Bt; int M, N, K; };

struct StaticOrder {
    int nM, nN, nwg, G, c;
    __host__ __device__ void init(int M, int N, int G_, int c_) { nM = M / BM; nN = N / BM; nwg = nM * nN; G = G_; c = c_; }
    __host__ __device__ bool next(int i, Unit& u) const {
        const long L = (long)i * G + c; if (L >= nwg) return false;
        int wgid = (int)L; { const int q = nwg / NXCD, r = nwg % NXCD, xcd = wgid % NXCD, off = wgid / NXCD; wgid = (xcd < r ? xcd * (q + 1) : r * (q + 1) + (xcd - r) * q) + off; }
        const int nig = WGM * nN, gid = wgid / nig, fm = gid * WGM, gsz = (nM - fm) < WGM ? (nM - fm) : WGM;
        u.pm = fm + ((wgid % nig) % gsz); u.pn = (wgid % nig) / gsz; return true;
    }
    __device__ __forceinline__ void a_ready(const Unit&) const {}
    __device__ __forceinline__ void done(const Unit&) const {}
};

__device__ __forceinline__ unsigned cvt_pk_bf16(float lo, float hi) { unsigned r; asm volatile("v_cvt_pk_bf16_f32 %0, %1, %2" : "=v"(r) : "v"(lo), "v"(hi)); return r; }
typedef float f32x2 __attribute__((ext_vector_type(2)));
__device__ __forceinline__ f32x2 gelu_pk(f32x2 v) {
    const f32x2 av = __builtin_elementwise_abs(v), d = av * 0.2316418882f + 1.0f;
    f32x2 t; t.x = __builtin_amdgcn_rcpf(d.x); t.y = __builtin_amdgcn_rcpf(d.y);
    f32x2 q = t * 0.5307027145f + (-0.7265760135f); q = q * t + 0.7107068705f; q = q * t + (-0.142248368f); q = q * t + 0.127414796f; q = q * t;
    const f32x2 s = (v * v) * (-0.72134752044f);
    f32x2 e; e.x = __builtin_amdgcn_exp2f(s.x); e.y = __builtin_amdgcn_exp2f(s.y);
    const f32x2 m = v * (q * e), r = v - m;
    f32x2 o; o.x = v.x < 0.f ? m.x : r.x; o.y = v.y < 0.f ? m.y : r.y; return o;
}

__device__ __forceinline__ float row_rstd(const float* ssq, int row, int fq) {
    const f32x4 p = *(const f32x4*)(ssq + (size_t)row * 16 + 4 * fq);
    float s = (p[0] + p[1]) + (p[2] + p[3]);
    s += __shfl_xor(s, 16); s += __shfl_xor(s, 32);
    return __builtin_amdgcn_rsqf(s * (1.0f / 1024.0f) + 1e-6f);
}
__device__ __forceinline__ float silu_f(float g) { return g * __builtin_amdgcn_rcpf(1.0f + __builtin_amdgcn_exp2f(g * -1.44269504089f)); }
__device__ __forceinline__ float sigm_f(float g) { return __builtin_amdgcn_rcpf(1.0f + __builtin_amdgcn_exp2f(g * -1.44269504089f)); }

struct EpiSwiGLU {
    static constexpr bool PERM = true, AFTER_DRAIN = false, LOADS_ACC = false;
    bf16_t* O; int ldo; const float* ssq;
    __device__ __forceinline__ void init_acc(f32x4 (&acc)[2][2][4][2], const Unit&, int, int, int, int) const {
#pragma unroll
        for (int a = 0; a < 2; ++a)
#pragma unroll
            for (int b = 0; b < 2; ++b)
#pragma unroll
                for (int m = 0; m < 4; ++m)
#pragma unroll
                    for (int n = 0; n < 2; ++n) acc[a][b][m][n] = (f32x4){0.f, 0.f, 0.f, 0.f};
    }
    __device__ __forceinline__ void operator()(const f32x4 (&acc)[2][2][4][2], const Unit& u, int wr, int wc, int fr, int fq) const {
        const int row0 = u.pm * BM + wr * 64 + fr, col0 = u.pn * HALF + wc * 32 + 8 * fq;
#pragma unroll
        for (int ai = 0; ai < 2; ++ai)
#pragma unroll
            for (int m = 0; m < 4; ++m) {
                const int row = row0 + ai * HALF + m * 16;
                const float rs = row_rstd(ssq, row, fq);
                const f32x4 g0 = acc[ai][0][m][0] * rs, g1 = acc[ai][0][m][1] * rs, u0 = acc[ai][1][m][0] * rs, u1 = acc[ai][1][m][1] * rs;
                u32x4 w;
                w.x = cvt_pk_bf16(silu_f(g0[0]) * u0[0], silu_f(g0[1]) * u0[1]); w.y = cvt_pk_bf16(silu_f(g0[2]) * u0[2], silu_f(g0[3]) * u0[3]);
                w.z = cvt_pk_bf16(silu_f(g1[0]) * u1[0], silu_f(g1[1]) * u1[1]); w.w = cvt_pk_bf16(silu_f(g1[2]) * u1[2], silu_f(g1[3]) * u1[3]);
                *(u32x4*)(O + (size_t)row * ldo + col0) = w;
            }
    }
};

struct EpiRes {
    static constexpr bool PERM = true, AFTER_DRAIN = false, LOADS_ACC = true;
    const float* base; float* out; bf16_t* xb; float* ssq;
    __device__ __forceinline__ void init_acc(f32x4 (&acc)[2][2][4][2], const Unit& u, int wr, int wc, int fr, int fq) const {
        const float* bp = base + (size_t)(u.pm * BM + wr * 64 + fr) * 1024 + u.pn * BM + wc * 32 + 8 * fq;
#pragma unroll
        for (int ai = 0; ai < 2; ++ai)
#pragma unroll
            for (int m = 0; m < 4; ++m)
#pragma unroll
                for (int bj = 0; bj < 2; ++bj) { const float* p = bp + (size_t)(ai * HALF + m * 16) * 1024 + bj * HALF; acc[ai][bj][m][0] = *(const f32x4*)p; acc[ai][bj][m][1] = *(const f32x4*)(p + 4); }
    }
    __device__ __forceinline__ void operator()(const f32x4 (&acc)[2][2][4][2], const Unit& u, int wr, int wc, int fr, int fq) const {
        const int row0 = u.pm * BM + wr * 64 + fr, col0 = u.pn * BM + wc * 32 + 8 * fq;
#pragma unroll
        for (int ai = 0; ai < 2; ++ai)
#pragma unroll
            for (int m = 0; m < 4; ++m) {
                const int row = row0 + ai * HALF + m * 16; float q = 0.f;
#pragma unroll
                for (int bj = 0; bj < 2; ++bj) {
                    const size_t off = (size_t)row * 1024 + col0 + bj * HALF;
                    const f32x4 v0 = acc[ai][bj][m][0], v1 = acc[ai][bj][m][1];
                    *(f32x4*)(out + off) = v0; *(f32x4*)(out + off + 4) = v1;
                    u32x4 pk; pk.x = cvt_pk_bf16(v0[0], v0[1]); pk.y = cvt_pk_bf16(v0[2], v0[3]); pk.z = cvt_pk_bf16(v1[0], v1[1]); pk.w = cvt_pk_bf16(v1[2], v1[3]);
                    *(u32x4*)(xb + off) = pk;
                    q += (v0[0] * v0[0] + v0[1] * v0[1]) + (v0[2] * v0[2] + v0[3] * v0[3]) + (v1[0] * v1[0] + v1[1] * v1[1]) + (v1[2] * v1[2] + v1[3] * v1[3]);
                }
                q += __shfl_xor(q, 16); q += __shfl_xor(q, 32);
                if (fq == 0) ssq[(size_t)row * 16 + u.pn * 4 + wc] = q;
            }
    }
};

struct EpiWin {
    static constexpr bool PERM = true, AFTER_DRAIN = false, LOADS_ACC = false;
    bf16_t* Z; int ldz; const float* ssq;
    __device__ __forceinline__ void init_acc(f32x4 (&acc)[2][2][4][2], const Unit&, int, int, int, int) const {
#pragma unroll
        for (int a = 0; a < 2; ++a)
#pragma unroll
            for (int b = 0; b < 2; ++b)
#pragma unroll
                for (int m = 0; m < 4; ++m)
#pragma unroll
                    for (int n = 0; n < 2; ++n) acc[a][b][m][n] = (f32x4){0.f, 0.f, 0.f, 0.f};
    }
    __device__ __forceinline__ void operator()(const f32x4 (&acc)[2][2][4][2], const Unit& u, int wr, int wc, int fr, int fq) const {
        const int row0 = u.pm * BM + wr * 64 + fr, cw = wc * 32 + 8 * fq;
#pragma unroll
        for (int ai = 0; ai < 2; ++ai)
#pragma unroll
            for (int m = 0; m < 4; ++m) {
                const int row = row0 + ai * HALF + m * 16;
                const float rs = row_rstd(ssq, row, fq);
                bf16_t* zr = Z + (size_t)row * ldz;
                if (u.pn >= 3 && u.pn < 6) {
                    const f32x4 a0 = acc[ai][0][m][0] * rs, a1 = acc[ai][0][m][1] * rs, g0 = acc[ai][1][m][0] * rs, g1 = acc[ai][1][m][1] * rs;
                    u32x4 pk;
                    pk.x = cvt_pk_bf16(a0[0] * sigm_f(g0[0]), a0[1] * sigm_f(g0[1])); pk.y = cvt_pk_bf16(a0[2] * sigm_f(g0[2]), a0[3] * sigm_f(g0[3]));
                    pk.z = cvt_pk_bf16(a1[0] * sigm_f(g1[0]), a1[1] * sigm_f(g1[1])); pk.w = cvt_pk_bf16(a1[2] * sigm_f(g1[2]), a1[3] * sigm_f(g1[3]));
                    *(u32x4*)(zr + 768 + 128 * (u.pn - 3) + cw) = pk;
                } else {
                    const int cbase = (u.pn < 3) ? 256 * u.pn : 1152;
#pragma unroll
                    for (int bj = 0; bj < 2; ++bj) {
                        f32x4 v0 = acc[ai][bj][m][0] * rs, v1 = acc[ai][bj][m][1] * rs;
                        if (u.pn < 3) { const f32x2 a = gelu_pk((f32x2){v0[0], v0[1]}), b = gelu_pk((f32x2){v0[2], v0[3]}), c = gelu_pk((f32x2){v1[0], v1[1]}), d = gelu_pk((f32x2){v1[2], v1[3]});
                            v0 = (f32x4){a.x, a.y, b.x, b.y}; v1 = (f32x4){c.x, c.y, d.x, d.y}; }
                        u32x4 pk; pk.x = cvt_pk_bf16(v0[0], v0[1]); pk.y = cvt_pk_bf16(v0[2], v0[3]); pk.z = cvt_pk_bf16(v1[0], v1[1]); pk.w = cvt_pk_bf16(v1[2], v1[3]);
                        *(u32x4*)(zr + cbase + bj * HALF + cw) = pk;
                    }
                }
            }
    }
};

template <class Epi, class Sched, bool ALIGN_EPI = false, bool SP2 = false>
__device__ __forceinline__ void gemm_phase(PG8_LAS unsigned char* lds, const Gemm g, const Sched& S, const Epi& E) {
    int tid = threadIdx.x; asm volatile("" : "+v"(tid));
    const int wid = __builtin_amdgcn_readfirstlane(tid >> 6), lane = tid & 63, wr = wid >> 2, wc = wid & 3, fr = lane & 15, fq = lane >> 4;
    const int K = g.K, nt = K / BK;
    unsigned voffA[2], voffB[2];
#pragma unroll
    for (int i = 0; i < 2; ++i) { int R, C; stage_rc(tid * 16 + i * 8192, R, C); const int Rb = Epi::PERM ? ((R & ~31) + perm32(R & 31)) : R;
        voffA[i] = (unsigned)(R * K + C) * 2u; voffB[i] = (unsigned)(Rb * K + C) * 2u; }
    const size_t kstep = (size_t)(BK * 2);
    const size_t hstep = (size_t)HALF * K * 2;
    const size_t tstep = 2 * hstep;
    const unsigned ldsw = (unsigned)wid * 1024u;
    const int aoff = lds_byte(wr * 64 + fr, fq * 8), boff = lds_byte(wc * 32 + fr, fq * 8);
#define PG8_SA(b, h) (((b) * 2 + (h)) * HTB)
#define PG8_SB(b, h) ((4 + (b) * 2 + (h)) * HTB)
#define PG8_STAGE(bufoff, gbase, voff) do { _Pragma("unroll") for (int _i = 0; _i < 2; ++_i) \
        __builtin_amdgcn_global_load_lds((const unsigned*)((const char*)(gbase) + (voff)[_i]), (PG8_LAS unsigned*)(lds + (bufoff) + ldsw + _i * 8192), 16, 0, 0); } while (0)
#define PG8_LDA(dst, b, h) do { _Pragma("unroll") for (int m = 0; m < 4; ++m) _Pragma("unroll") for (int k = 0; k < 2; ++k) dst[m][k] = *(const PG8_LAS bf16x8*)(lds + PG8_SA(b, h) + aoff + m * 2048 + k * 1024); } while (0)
#define PG8_LDB(dst, b, h) do { _Pragma("unroll") for (int n = 0; n < 2; ++n) _Pragma("unroll") for (int k = 0; k < 2; ++k) dst[n][k] = *(const PG8_LAS bf16x8*)(lds + PG8_SB(b, h) + boff + n * 2048 + k * 1024); } while (0)
#define PG8_MMA(ai, bj, At, Bt) do { __builtin_amdgcn_s_setprio(1); _Pragma("unroll") for (int m = 0; m < 4; ++m) _Pragma("unroll") for (int n = 0; n < 2; ++n) _Pragma("unroll") for (int k = 0; k < 2; ++k) \
        acc[ai][bj][m][n] = __builtin_amdgcn_mfma_f32_16x16x32_bf16(Bt[n][k], At[m][k], acc[ai][bj][m][n], 0, 0, 0); __builtin_amdgcn_s_setprio(0); } while (0)
#define PG8_WAIT_V(n) asm volatile("s_waitcnt vmcnt(" #n ")" ::: "memory")
#define PG8_WAIT_L(n) asm volatile("s_waitcnt lgkmcnt(" #n ")" ::: "memory")
#define PG8_BAR __builtin_amdgcn_s_barrier()
#define PG8_SCHED __builtin_amdgcn_sched_barrier(0)
#define PG8_PIN_ACC() do { _Pragma("unroll") for (int a_ = 0; a_ < 2; ++a_) _Pragma("unroll") for (int b_ = 0; b_ < 2; ++b_) _Pragma("unroll") for (int m_ = 0; m_ < 4; ++m_) \
        asm volatile("" : "+v"(acc[a_][b_][m_][0]), "+v"(acc[a_][b_][m_][1])); } while (0)
    Unit cur, nxt; int ui = 0;
    if (!S.next(0, cur)) return;
    f32x4 acc[2][2][4][2];
    E.init_acc(acc, cur, wr, wc, fr, fq);
    bf16x8 At[4][2], B0[2][2], B1[2][2];
    const char* cA = (const char*)g.A + (size_t)cur.pm * tstep; const char* cB = (const char*)g.Bt + (size_t)cur.pn * tstep;
    S.a_ready(cur);
    if constexpr (SP2) {
        PG8_STAGE(PG8_SB(0, 0), cB, voffB); PG8_STAGE(PG8_SB(0, 1), cB + hstep, voffB); PG8_STAGE(PG8_SA(0, 0), cA, voffA); PG8_STAGE(PG8_SA(0, 1), cA + hstep, voffA);
        if (wr == 1) PG8_BAR;
        PG8_WAIT_V(2); PG8_BAR;
        PG8_STAGE(PG8_SB(1, 0), cB + kstep, voffB); PG8_STAGE(PG8_SA(1, 0), cA + kstep, voffA); PG8_STAGE(PG8_SB(1, 1), cB + hstep + kstep, voffB);
        PG8_WAIT_V(6); PG8_BAR;
    } else {
        PG8_STAGE(PG8_SB(0, 0), cB, voffB); PG8_STAGE(PG8_SA(0, 0), cA, voffA); PG8_STAGE(PG8_SB(0, 1), cB + hstep, voffB); PG8_STAGE(PG8_SA(0, 1), cA + hstep, voffA);
        if (wr == 1) PG8_BAR;
        PG8_WAIT_V(4); PG8_BAR;
        PG8_STAGE(PG8_SB(1, 0), cB + kstep, voffB); PG8_STAGE(PG8_SA(1, 0), cA + kstep, voffA); PG8_STAGE(PG8_SB(1, 1), cB + hstep + kstep, voffB);
        PG8_WAIT_V(6); PG8_BAR;
    }
    if constexpr (Epi::LOADS_ACC) PG8_PIN_ACC();
    for (;;) {
        const bool has_next = S.next(ui + 1, nxt);
        const char* nA = has_next ? (const char*)g.A + (size_t)nxt.pm * tstep : cA; const char* nB = has_next ? (const char*)g.Bt + (size_t)nxt.pn * tstep : cB;
        for (int t = 0; t < nt; t += 2) {
            const bool last = (t == nt - 2);
            const char* a1 = cA + (size_t)(t + 1) * kstep;
            const char* a2 = last ? nA : cA + (size_t)(t + 2) * kstep; const char* b2 = last ? nB : cB + (size_t)(t + 2) * kstep;
            const char* a3 = a2 + kstep; const char* b3 = b2 + kstep;
            if (last && has_next) S.a_ready(nxt);
            if constexpr (SP2) {
            PG8_LDB(B0, 0, 0); PG8_LDB(B1, 0, 1); PG8_SCHED; PG8_LDA(At, 0, 0); PG8_STAGE(PG8_SA(1, 1), a1 + hstep, voffA);
            PG8_WAIT_V(8); PG8_WAIT_L(0); PG8_BAR; PG8_MMA(0, 0, At, B0); PG8_MMA(0, 1, At, B1); PG8_BAR; PG8_SCHED;
            PG8_LDA(At, 0, 1); PG8_STAGE(PG8_SB(0, 0), b2, voffB); PG8_STAGE(PG8_SB(0, 1), b2 + hstep, voffB); PG8_STAGE(PG8_SA(0, 0), a2, voffA);
            PG8_WAIT_V(8); PG8_WAIT_L(0); PG8_BAR; PG8_MMA(1, 0, At, B0); PG8_MMA(1, 1, At, B1); PG8_BAR; PG8_SCHED;
            PG8_LDB(B0, 1, 0); PG8_LDB(B1, 1, 1); PG8_SCHED; PG8_LDA(At, 1, 0); PG8_STAGE(PG8_SA(0, 1), a2 + hstep, voffA);
            PG8_WAIT_V(8); PG8_WAIT_L(0); PG8_BAR; PG8_MMA(0, 0, At, B0); PG8_MMA(0, 1, At, B1); PG8_BAR; PG8_SCHED;
            PG8_LDA(At, 1, 1); PG8_STAGE(PG8_SB(1, 0), b3, voffB); PG8_STAGE(PG8_SB(1, 1), b3 + hstep, voffB); PG8_STAGE(PG8_SA(1, 0), a3, voffA);
            PG8_WAIT_V(8); PG8_WAIT_L(0); PG8_BAR; PG8_MMA(1, 0, At, B0); PG8_MMA(1, 1, At, B1); PG8_BAR; PG8_SCHED;
            } else {
            PG8_LDB(B0, 0, 0); PG8_SCHED; PG8_LDA(At, 0, 0); PG8_STAGE(PG8_SA(1, 1), a1 + hstep, voffA);
            PG8_WAIT_L(8); PG8_BAR; PG8_WAIT_L(0); PG8_MMA(0, 0, At, B0); PG8_BAR; PG8_SCHED;
            PG8_LDB(B1, 0, 1); PG8_STAGE(PG8_SB(0, 0), b2, voffB);
            PG8_BAR; PG8_WAIT_L(0); PG8_MMA(0, 1, At, B1); PG8_BAR;
            PG8_LDA(At, 0, 1); PG8_STAGE(PG8_SA(0, 0), a2, voffA);
            PG8_BAR; PG8_WAIT_L(0); PG8_MMA(1, 0, At, B0); PG8_BAR; PG8_SCHED;
            PG8_STAGE(PG8_SB(0, 1), b2 + hstep, voffB);
            PG8_WAIT_V(6); PG8_BAR; PG8_MMA(1, 1, At, B1); PG8_BAR;
            PG8_LDB(B0, 1, 0); PG8_SCHED; PG8_LDA(At, 1, 0); PG8_STAGE(PG8_SA(0, 1), a2 + hstep, voffA);
            PG8_WAIT_L(8); PG8_BAR; PG8_WAIT_L(0); PG8_MMA(0, 0, At, B0); PG8_BAR; PG8_SCHED;
            PG8_LDB(B1, 1, 1); PG8_STAGE(PG8_SB(1, 0), b3, voffB);
            PG8_BAR; PG8_WAIT_L(0); PG8_MMA(0, 1, At, B1); PG8_BAR;
            PG8_LDA(At, 1, 1); PG8_STAGE(PG8_SA(1, 0), a3, voffA);
            PG8_BAR; PG8_WAIT_L(0); PG8_MMA(1, 0, At, B0); PG8_BAR; PG8_SCHED;
            PG8_STAGE(PG8_SB(1, 1), b3 + hstep, voffB);
            PG8_WAIT_V(6); PG8_BAR; PG8_MMA(1, 1, At, B1); PG8_BAR;
            }
        }
        if constexpr (ALIGN_EPI) { if (wr == 0) PG8_BAR; }
        if constexpr (!Epi::AFTER_DRAIN) { E(acc, cur, wr, wc, fr, fq); S.done(cur); }
        if (!has_next) break;
        E.init_acc(acc, nxt, wr, wc, fr, fq);
        if constexpr (Epi::LOADS_ACC) PG8_PIN_ACC();
        cur = nxt; cA = nA; cB = nB; ++ui;
        if constexpr (ALIGN_EPI) { if (wr == 1) PG8_BAR; }
    }
    PG8_WAIT_V(0);
    if constexpr (!ALIGN_EPI) { if (wr == 0) PG8_BAR; }
    PG8_BAR;
    if constexpr (Epi::AFTER_DRAIN) { E.fused(acc, cur, wr, wc, fr, fq, lds, wid, lane); S.done(cur); }
#undef PG8_SA
#undef PG8_SB
#undef PG8_STAGE
#undef PG8_LDA
#undef PG8_LDB
#undef PG8_MMA
#undef PG8_WAIT_V
#undef PG8_WAIT_L
#undef PG8_BAR
#undef PG8_SCHED
#undef PG8_PIN_ACC
}
}

#ifndef MK_PER_PHASE
#define MK_PER_PHASE 0
#endif
#ifndef MK_PROBE
#define MK_PROBE 0
#endif
#define LAS __attribute__((address_space(3)))
using pg8::bf16_t; using pg8::f32x4; using pg8::u32x4; using pg8::bf16x8;
typedef unsigned u32x2 __attribute__((ext_vector_type(2)));

constexpr int M = 16384, SEQ = 4096, D = 1024, FF = 2816, DIN = 1792, NLAYER = 2;
constexpr int ZLD = 1408;
constexpr float EPS = 1e-6f;
constexpr int NPHASE = 16;
constexpr size_t MiB = 1u << 20;
constexpr size_t WS_SSQ = 1 * MiB, WS_W = 2 * MiB, WS_XB = 80 * MiB, WS_H = 112 * MiB, WS_Z = 112 * MiB, WS_Y = 156 * MiB;
constexpr size_t W_GU1 = 0, W_D1 = 11534336, W_IN = 17301504, W_OUT = 20971520, W_GU2 = 23068672, W_D2 = 34603008, W_LAYER = 40370176;
static_assert(WS_W + 2 * W_LAYER <= WS_XB && WS_Z + (size_t)M * ZLD * 2 <= WS_Y && WS_Y + (size_t)M * D * 2 <= WS_H + (size_t)M * FF * 2 && WS_H + (size_t)M * FF * 2 <= 256 * MiB, "ws map");
constexpr int LDS_BYTES = 147456;

__device__ __forceinline__ unsigned f2bf(float f) { unsigned u = __builtin_bit_cast(unsigned, f); return (u + 0x7fffu + ((u >> 16) & 1u)) >> 16; }
__device__ __forceinline__ unsigned pk2(float lo, float hi) { return f2bf(lo) | (f2bf(hi) << 16); }
__device__ __forceinline__ float bf_lo(unsigned w) { return __uint_as_float(w << 16); }
__device__ __forceinline__ float bf_hi(unsigned w) { return __uint_as_float(w & 0xffff0000u); }
__device__ __forceinline__ float wave_sum(float v) {
#pragma unroll
    for (int o = 1; o < 64; o <<= 1) v += __shfl_xor(v, o);
    return v;
}
__device__ __forceinline__ void ld6(const bf16_t* p, float (&v)[6]) {
    const unsigned* q = (const unsigned*)p; const unsigned a = q[0], b = q[1], c = q[2];
    v[0] = bf_lo(a); v[1] = bf_hi(a); v[2] = bf_lo(b); v[3] = bf_hi(b); v[4] = bf_lo(c); v[5] = bf_hi(c);
}

__device__ __forceinline__ int dst_row(int mode, int c) {
    if (mode == 0) return c;
    if (mode == 1) return 256 * (c >> 7) + (c & 127);
    if (mode == 2) return 256 * (c >> 7) + 128 + (c & 127);
    if (c < 768 || c >= 1536) return c;
    if (c < 1152) { const int j = c - 768; return 768 + 256 * (j >> 7) + (j & 127); }
    { const int j = c - 1152; return 768 + 256 * (j >> 7) + 128 + (j & 127); }
}
__device__ __forceinline__ void p0_transpose_item(const float* W, int K, int N, bf16_t* WT, int mode, const float* gk, float cscale, LAS float* scr, int item, int lane) {
    const int nblk = N / 64, kb = item / nblk, nb = item % nblk, k0 = 64 * kb, n0 = 64 * nb;
    const float* src = W + (size_t)k0 * N + n0;
    float v[64];
#pragma unroll
    for (int i = 0; i < 64; ++i) v[i] = src[(size_t)i * N + lane];
#pragma unroll
    for (int i = 0; i < 64; ++i) scr[i * 65 + lane] = v[i];
    asm volatile("s_waitcnt lgkmcnt(0)" ::: "memory");
    const int c = lane & 7; const int dr0 = dst_row(mode, n0);
    f32x4 g0 = (f32x4){cscale, cscale, cscale, cscale}, g1 = g0;
    if (gk) { g0 = *(const f32x4*)(gk + k0 + 8 * c); g1 = *(const f32x4*)(gk + k0 + 8 * c + 4); }
#pragma unroll
    for (int j = 0; j < 8; ++j) { const int n = (lane >> 3) + 8 * j; const LAS float* s = scr + (8 * c) * 65 + n;
        u32x4 o; o.x = pk2(s[0 * 65] * g0[0], s[1 * 65] * g0[1]); o.y = pk2(s[2 * 65] * g0[2], s[3 * 65] * g0[3]); o.z = pk2(s[4 * 65] * g1[0], s[5 * 65] * g1[1]); o.w = pk2(s[6 * 65] * g1[2], s[7 * 65] * g1[3]);
        *(u32x4*)(WT + (size_t)(dr0 + n) * K + k0 + 8 * c) = o; }
    asm volatile("s_waitcnt lgkmcnt(0)" ::: "memory");
}

#define XB_TMO      128
#define XB_XCNT(j)  (256  + 64 * (j))
#define XB_XSUB(j)  (1280 + 64 * (j))
#define XB_XGEN(j)  (2304 + 64 * (j))
#define XB_TOP      3328
#define XB_TOPGEN   3392
#define XCD_BAR_WORDS 3456
#define XB_SPIN_CAP (1u << 18)

__device__ __forceinline__ unsigned xb_ld(unsigned* p)              { return __hip_atomic_load(p, __ATOMIC_RELAXED, __HIP_MEMORY_SCOPE_AGENT); }
__device__ __forceinline__ unsigned xb_add(unsigned* p, unsigned v) { return __hip_atomic_fetch_add(p, v, __ATOMIC_RELAXED, __HIP_MEMORY_SCOPE_AGENT); }
__device__ __forceinline__ unsigned xb_xcc_id() { return (unsigned)__builtin_amdgcn_s_getreg((3 << 11) | 20) & 0xFu; }
#define XB_SPIN(cond, bar) do { unsigned _sp = 0; while (cond) { __builtin_amdgcn_s_sleep(1); \
    if ((++_sp & 255u) == 0u) { if (xb_ld(&(bar)[XB_TMO])) break; if (_sp > XB_SPIN_CAP) { atomicAdd(&(bar)[XB_TMO], 1u); break; } } } } while (0)

struct XcdBarrier {
    unsigned* bar; unsigned x;
    volatile LAS unsigned* st;
};

__device__ __forceinline__ XcdBarrier xcd_barrier_post(unsigned* bar, volatile LAS unsigned* st) {
    XcdBarrier b; b.bar = bar; b.x = xb_xcc_id(); b.st = st;
    if (threadIdx.x == 0) (void)xb_add(&bar[XB_XCNT(b.x)], 1u);
    return b;
}
__device__ __forceinline__ void xcd_barrier_complete(unsigned* bar, unsigned x, unsigned& nloc, unsigned& nx) {
    const unsigned G = gridDim.x * gridDim.y * gridDim.z;
    unsigned sum, cnt, mine, sp = 0u;
    for (;;) {
        sum = 0u; cnt = 0u; mine = 0u;
#pragma unroll
        for (unsigned j = 0; j < 16; ++j) { const unsigned c = xb_ld(&bar[XB_XCNT(j)]); sum += c; cnt += (c > 0u) ? 1u : 0u; mine = (j == x) ? c : mine; }
        if (sum == G) break;
        __builtin_amdgcn_s_sleep(1);
        if ((++sp & 255u) == 0u) { if (xb_ld(&bar[XB_TMO])) break; if (sp > XB_SPIN_CAP) { atomicAdd(&bar[XB_TMO], 1u); break; } }
    }
    nloc = mine > 0u ? mine : 1u; nx = cnt > 0u ? cnt : 1u;
}

__device__ __forceinline__ void xcd_barrier(const XcdBarrier& b) {
    asm volatile("s_waitcnt vmcnt(0)" ::: "memory");
    __syncthreads();
    if (threadIdx.x == 0) {
        unsigned* bar = b.bar;
        __builtin_amdgcn_s_waitcnt(0);
        unsigned nloc = b.st[0], nx = b.st[1];
        if (nloc == 0u) { xcd_barrier_complete(bar, b.x, nloc, nx); b.st[0] = nloc; b.st[1] = nx; }
        const unsigned old = xb_add(&bar[XB_XSUB(b.x)], 1u);
        const unsigned gen = old / nloc;
        if (old + 1u == (gen + 1u) * nloc) {
            __builtin_amdgcn_fence(__ATOMIC_RELEASE, "agent");
            asm volatile("s_waitcnt vmcnt(0)" ::: "memory");
            const unsigned og = xb_add(&bar[XB_TOP], 1u);
            const unsigned tg = og / nx;
            if (og + 1u == (tg + 1u) * nx) xb_add(&bar[XB_TOPGEN], 1u);
            else XB_SPIN(xb_ld(&bar[XB_TOPGEN]) == tg, bar);
            __builtin_amdgcn_fence(__ATOMIC_ACQUIRE, "agent");
            xb_add(&bar[XB_XGEN(b.x)], 1u);
            asm volatile("s_waitcnt vmcnt(0)" ::: "memory");
        } else {
            XB_SPIN(xb_ld(&bar[XB_XGEN(b.x)]) == gen, bar);
            __builtin_amdgcn_fence(__ATOMIC_ACQUIRE, "agent");
            asm volatile("s_waitcnt vmcnt(0)" ::: "memory");
        }
    }
    __syncthreads();
}

struct Args { const float* in[23]; float* out; unsigned char* ws; int ph_lo, ph_hi; };

__device__ __forceinline__ void prologue_phase(const Args& args, LAS unsigned char* lds, int lane, int wave, int G, int bx) {
    unsigned char* ws = args.ws;
    LAS float* scr = (LAS float*)(lds + wave * 16640);
    const int gw = bx * 8 + wave, NGW = G * 8;
    constexpr int I_G = (D / 64) * (FF / 64), I_D = (FF / 64) * (D / 64), I_IN = (D / 64) * (DIN / 64), I_OUT = (D / 64) * (D / 64);
    constexpr int I_LAYER = 4 * I_G + 2 * I_D + I_IN + I_OUT;
#pragma unroll 1
    for (int it = gw; it < NLAYER * I_LAYER; it += NGW) {
        const int l = it / I_LAYER; int r = it % I_LAYER;
        unsigned char* wl = ws + WS_W + (size_t)l * W_LAYER;
        const size_t oG = (size_t)l * D * FF, oD = (size_t)l * FF * D;
        const float* W; const float* gk; bf16_t* WT; int K, N, mode;
        if (r < I_G) { W = args.in[2] + oG; K = D; N = FF; WT = (bf16_t*)(wl + W_GU1); mode = 1; gk = args.in[1] + l * D; }
        else if ((r -= I_G) < I_G) { W = args.in[3] + oG; K = D; N = FF; WT = (bf16_t*)(wl + W_GU1); mode = 2; gk = args.in[1] + l * D; }
        else if ((r -= I_G) < I_D) { W = args.in[4] + oD; K = FF; N = D; WT = (bf16_t*)(wl + W_D1); mode = 0; gk = nullptr; }
        else if ((r -= I_D) < I_IN) { W = args.in[6] + (size_t)l * D * DIN; K = D; N = DIN; WT = (bf16_t*)(wl + W_IN); mode = 3; gk = args.in[5] + l * D; }
        else if ((r -= I_IN) < I_OUT) { W = args.in[17] + (size_t)l * D * D; K = D; N = D; WT = (bf16_t*)(wl + W_OUT); mode = 0; gk = nullptr; }
        else if ((r -= I_OUT) < I_G) { W = args.in[19] + oG; K = D; N = FF; WT = (bf16_t*)(wl + W_GU2); mode = 1; gk = args.in[18] + l * D; }
        else if ((r -= I_G) < I_G) { W = args.in[20] + oG; K = D; N = FF; WT = (bf16_t*)(wl + W_GU2); mode = 2; gk = args.in[18] + l * D; }
        else { r -= I_G; W = args.in[21] + oD; K = FF; N = D; WT = (bf16_t*)(wl + W_D2); mode = 0; gk = nullptr; }
        p0_transpose_item(W, K, N, WT, mode, gk, (K == FF) ? 0.5f : 1.0f, scr, r, lane);
    }
    const float* x = args.in[0]; bf16_t* xb = (bf16_t*)(ws + WS_XB); float* ssq = (float*)(ws + WS_SSQ);
#pragma unroll 1
    for (int m = 2 * gw; m < M; m += 2 * NGW) {
        const f32x4* xr = (const f32x4*)(x + (size_t)m * D) + lane;
        f32x4 v[8]; float s0 = 0.f, s1 = 0.f;
#pragma unroll
        for (int j = 0; j < 8; ++j) v[j] = xr[64 * j];
#pragma unroll
        for (int j = 0; j < 4; ++j) { s0 += (v[j][0] * v[j][0] + v[j][1] * v[j][1]) + (v[j][2] * v[j][2] + v[j][3] * v[j][3]);
                                      s1 += (v[j + 4][0] * v[j + 4][0] + v[j + 4][1] * v[j + 4][1]) + (v[j + 4][2] * v[j + 4][2] + v[j + 4][3] * v[j + 4][3]); }
        s0 = wave_sum(s0); s1 = wave_sum(s1);
        u32x2* o8 = (u32x2*)(xb + (size_t)m * D) + lane;
#pragma unroll
        for (int j = 0; j < 8; ++j) { u32x2 o; o.x = pk2(v[j][0], v[j][1]); o.y = pk2(v[j][2], v[j][3]); o8[64 * j] = o; }
        if (lane < 32) ssq[(size_t)m * 16 + lane] = (lane == 0) ? s0 : ((lane == 16) ? s1 : 0.f);
    }
}

__device__ __forceinline__ void final_phase(const Args& args, int lane, int wave, int G, int bx) {
    const float* ssq = (const float*)(args.ws + WS_SSQ); const float* g = args.in[22]; float* out = args.out;
    const int gw = bx * 8 + wave, NGW = G * 8;
    f32x4 gv[4];
#pragma unroll
    for (int j = 0; j < 4; ++j) gv[j] = ((const f32x4*)g)[lane + 64 * j];
    for (int m = gw; m < M; m += NGW) {
        float s = (lane < 16) ? ssq[(size_t)m * 16 + lane] : 0.f;
        s = wave_sum(s);
        const float rs = 1.0f / sqrtf(s * (1.0f / D) + EPS);
        f32x4* xr = (f32x4*)(out + (size_t)m * D) + lane;
#pragma unroll
        for (int j = 0; j < 4; ++j) { f32x4 v = xr[64 * j]; v = v * rs * gv[j]; xr[64 * j] = v; }
    }
}

constexpr int VT_LD = 136, PW_LD = 72, PS_LD = 264, GS_LD = 384;
constexpr int L_VT = 0, L_PS = 52224, L_PW = L_PS + 79 * PS_LD * 2, L_END1 = L_PW + 4 * 64 * PW_LD * 2;
constexpr int L_GS = 0, L_CW = 94 * GS_LD * 2, L_END2 = L_CW + 31 * 384 * 4;
static_assert(L_END1 <= LDS_BYTES - 16 && L_END2 <= LDS_BYTES - 16, "lds map");
typedef float f32x2_t __attribute__((ext_vector_type(2)));

__device__ __forceinline__ void mixer_phase(LAS unsigned char* lds, const bf16_t* Z, bf16_t* Y,
        const float* sgu_g, const float* sgu_b, const float* wsp, const float* bsp,
        const float* cw, const float* cbias, const float* cln_g, const float* cln_b,
        const float* pw, const float* ps, int tid, int lane, int wave, int G, int bx) {
    LAS bf16_t* VT = (LAS bf16_t*)(lds + L_VT);
    LAS bf16_t* PS = (LAS bf16_t*)(lds + L_PS);
    LAS bf16_t* PW = (LAS bf16_t*)(lds + L_PW);
    LAS bf16_t* GS = (LAS bf16_t*)(lds + L_GS);
    LAS float* CW = (LAS float*)(lds + L_CW);
    const int fr = lane & 15, kq = lane >> 4;
#pragma unroll 1
    for (int unit = bx; unit < 256; unit += G) {
        const int chunk = unit >> 1, half = unit & 1;
        const int cb0 = chunk * 128, t0 = cb0 + 64 * half, tpos0 = t0 & (SEQ - 1);
        __syncthreads();
        for (int i = tid; i < 4 * 64 * 64; i += 512) { const int g = i >> 12, c = (i >> 6) & 63, d = i & 63; PW[(g * 64 + d) * PW_LD + c] = (bf16_t)f2bf(pw[i]); }
        for (int i = tid; i < 79 * 32; i += 512) { const int r = i >> 5, c16 = i & 31;
            u32x4 v = (u32x4){0u, 0u, 0u, 0u};
            if (tpos0 - 15 + r >= 0) v = *(const u32x4*)(Z + (size_t)(t0 - 15 + r) * ZLD + 1152 + 8 * c16);
            *(LAS u32x4*)(PS + r * PS_LD + 8 * c16) = v; }
        {
            float gg[6], bb[6];
#pragma unroll
            for (int k = 0; k < 6; ++k) { gg[k] = sgu_g[6 * lane + k]; bb[k] = sgu_b[6 * lane + k]; }
            unsigned raw[16][3];
#pragma unroll
            for (int qi = 0; qi < 16; ++qi) { const unsigned* q = (const unsigned*)(Z + (size_t)(cb0 + 16 * wave + qi) * ZLD + 384 + 6 * lane); raw[qi][0] = q[0]; raw[qi][1] = q[1]; raw[qi][2] = q[2]; }
#pragma unroll
            for (int qi = 0; qi < 16; ++qi) {
                const int q = 16 * wave + qi;
                float v[6] = {bf_lo(raw[qi][0]), bf_hi(raw[qi][0]), bf_lo(raw[qi][1]), bf_hi(raw[qi][1]), bf_lo(raw[qi][2]), bf_hi(raw[qi][2])};
                const float s = ((v[0] + v[1]) + (v[2] + v[3])) + (v[4] + v[5]);
                const float mean = wave_sum(s) * (1.0f / 384.0f);
                float s2 = 0.f;
#pragma unroll
                for (int k = 0; k < 6; ++k) { v[k] -= mean; s2 += v[k] * v[k]; }
                const float rstd = 1.0f / sqrtf(wave_sum(s2) * (1.0f / 384.0f) + EPS);
                if ((lane >> 5) == half) {
#pragma unroll
                    for (int k = 0; k < 6; ++k) VT[(6 * (lane & 31) + k) * VT_LD + q] = (bf16_t)f2bf(v[k] * rstd * gg[k] + bb[k]);
                }
            }
        }
        __syncthreads();
        {
            const int p = 16 * wave + fr;
            const int nks = (wave >> 1) + 1;
            const size_t trow = (size_t)(cb0 + p);
#pragma unroll
            for (int hl = 0; hl < 3; ++hl) {
                const int h = 3 * half + hl;
                f32x4 w0[4], w1[4];
#pragma unroll
                for (int ks = 0; ks < 4; ++ks) if (ks < nks) { const float* wp = wsp + ((size_t)h * 128 + p) * 128 + 32 * ks + 8 * kq; w0[ks] = *(const f32x4*)wp; w1[ks] = *(const f32x4*)(wp + 4); }
                u32x2 uu[4];
#pragma unroll
                for (int ct = 0; ct < 4; ++ct) uu[ct] = *(const u32x2*)(Z + trow * ZLD + h * 64 + 16 * ct + 4 * kq);
                const float bs = bsp[h * 128 + p];
                f32x4 accd[4];
#pragma unroll
                for (int ct = 0; ct < 4; ++ct) accd[ct] = (f32x4){0.f, 0.f, 0.f, 0.f};
#pragma unroll
                for (int ks = 0; ks < 4; ++ks) if (ks < nks) {
                    const int q0 = 32 * ks + 8 * kq;
                    u32x4 bw;
                    bw.x = pk2(q0 + 0 <= p ? w0[ks][0] : 0.f, q0 + 1 <= p ? w0[ks][1] : 0.f); bw.y = pk2(q0 + 2 <= p ? w0[ks][2] : 0.f, q0 + 3 <= p ? w0[ks][3] : 0.f);
                    bw.z = pk2(q0 + 4 <= p ? w1[ks][0] : 0.f, q0 + 5 <= p ? w1[ks][1] : 0.f); bw.w = pk2(q0 + 6 <= p ? w1[ks][2] : 0.f, q0 + 7 <= p ? w1[ks][3] : 0.f);
                    const bf16x8 bfrag = __builtin_bit_cast(bf16x8, bw);
#pragma unroll
                    for (int ct = 0; ct < 4; ++ct) {
                        const bf16x8 afrag = *(const LAS bf16x8*)(VT + (hl * 64 + 16 * ct + fr) * VT_LD + q0);
                        accd[ct] = __builtin_amdgcn_mfma_f32_16x16x32_bf16(afrag, bfrag, accd[ct], 0, 0, 0);
                    }
                }
#pragma unroll
                for (int ct = 0; ct < 4; ++ct) {
                    const int c0 = h * 64 + 16 * ct + 4 * kq;
                    u32x2 o;
                    o.x = pk2(bf_lo(uu[ct].x) * (accd[ct][0] + bs), bf_hi(uu[ct].x) * (accd[ct][1] + bs));
                    o.y = pk2(bf_lo(uu[ct].y) * (accd[ct][2] + bs), bf_hi(uu[ct].y) * (accd[ct][3] + bs));
                    *(u32x2*)(Y + trow * D + c0) = o;
                }
            }
        }
        {
            const int tl = 16 * (wave & 3) + fr, t = t0 + tl, tpos = tpos0 + tl;
#pragma unroll 1
            for (int gi = 0; gi < 2; ++gi) {
                const int g = 2 * (wave >> 2) + gi, win = 2 << g;
                const float inv = 1.0f / (float)((tpos + 1 < win) ? (tpos + 1) : win);
                f32x4 accd[4];
#pragma unroll
                for (int dt = 0; dt < 4; ++dt) accd[dt] = (f32x4){0.f, 0.f, 0.f, 0.f};
#pragma unroll
                for (int ks = 0; ks < 2; ++ks) {
                    const int c0 = g * 64 + 32 * ks + 8 * kq;
                    const LAS bf16_t* pp = PS + (15 + tl) * PS_LD + c0;
                    const u32x4 cur = *(const LAS u32x4*)pp;
                    float s[8] = {bf_lo(cur.x), bf_hi(cur.x), bf_lo(cur.y), bf_hi(cur.y), bf_lo(cur.z), bf_hi(cur.z), bf_lo(cur.w), bf_hi(cur.w)};
#pragma unroll 4
                    for (int i = 1; i < win; ++i) {
                        const u32x4 r = *(const LAS u32x4*)(pp - i * PS_LD);
                        s[0] += bf_lo(r.x); s[1] += bf_hi(r.x); s[2] += bf_lo(r.y); s[3] += bf_hi(r.y);
                        s[4] += bf_lo(r.z); s[5] += bf_hi(r.z); s[6] += bf_lo(r.w); s[7] += bf_hi(r.w);
                    }
                    u32x4 bw;
                    bw.x = pk2(s[0] * inv - bf_lo(cur.x), s[1] * inv - bf_hi(cur.x)); bw.y = pk2(s[2] * inv - bf_lo(cur.y), s[3] * inv - bf_hi(cur.y));
                    bw.z = pk2(s[4] * inv - bf_lo(cur.z), s[5] * inv - bf_hi(cur.z)); bw.w = pk2(s[6] * inv - bf_lo(cur.w), s[7] * inv - bf_hi(cur.w));
                    const bf16x8 bfrag = __builtin_bit_cast(bf16x8, bw);
#pragma unroll
                    for (int dt = 0; dt < 4; ++dt) {
                        const bf16x8 afrag = *(const LAS bf16x8*)(PW + (g * 64 + 16 * dt + fr) * PW_LD + 32 * ks + 8 * kq);
                        accd[dt] = __builtin_amdgcn_mfma_f32_16x16x32_bf16(afrag, bfrag, accd[dt], 0, 0, 0);
                    }
                }
#pragma unroll
                for (int dt = 0; dt < 4; ++dt) {
                    const int d0 = g * 64 + 16 * dt + 4 * kq;
                    const f32x4 sc = *(const f32x4*)(ps + d0);
                    u32x2 o; o.x = pk2(accd[dt][0] * sc[0], accd[dt][1] * sc[1]); o.y = pk2(accd[dt][2] * sc[2], accd[dt][3] * sc[3]);
                    *(u32x2*)(Y + (size_t)t * D + 768 + d0) = o;
                }
            }
        }
        __syncthreads();
        for (int i = tid; i < 31 * 384 / 4; i += 512) ((LAS f32x4*)CW)[i] = ((const f32x4*)cw)[i];
        for (int i = tid; i < 94 * 48; i += 512) { const int r = i / 48, c16 = i % 48;
            u32x4 v = (u32x4){0u, 0u, 0u, 0u};
            if (tpos0 - 30 + r >= 0) v = *(const u32x4*)(Z + (size_t)(t0 - 30 + r) * ZLD + 768 + 8 * c16);
            *(LAS u32x4*)(GS + r * GS_LD + 8 * c16) = v; }
        __syncthreads();
        {
            f32x2_t acc[8][3], wn[8][3];
            {
                const f32x2_t b0 = *(const f32x2_t*)(cbias + 6 * lane), b1 = *(const f32x2_t*)(cbias + 6 * lane + 2), b2 = *(const f32x2_t*)(cbias + 6 * lane + 4);
#pragma unroll
                for (int i = 0; i < 8; ++i) { acc[i][0] = b0; acc[i][1] = b1; acc[i][2] = b2; }
            }
            const LAS unsigned* gbase = (const LAS unsigned*)(GS + (8 * wave) * GS_LD + 6 * lane);
#pragma unroll
            for (int r = 0; r < 7; ++r) { const LAS unsigned* gp = gbase + r * (GS_LD / 2); const unsigned a = gp[0], b = gp[1], c = gp[2];
                wn[r][0] = (f32x2_t){bf_lo(a), bf_hi(a)}; wn[r][1] = (f32x2_t){bf_lo(b), bf_hi(b)}; wn[r][2] = (f32x2_t){bf_lo(c), bf_hi(c)}; }
#pragma unroll
            for (int j = 0; j < 31; ++j) {
                { const LAS unsigned* gp = gbase + (j + 7) * (GS_LD / 2); const unsigned a = gp[0], b = gp[1], c = gp[2]; const int sl = (j + 7) & 7;
                  wn[sl][0] = (f32x2_t){bf_lo(a), bf_hi(a)}; wn[sl][1] = (f32x2_t){bf_lo(b), bf_hi(b)}; wn[sl][2] = (f32x2_t){bf_lo(c), bf_hi(c)}; }
                const LAS f32x2_t* wp = (const LAS f32x2_t*)(CW + j * 384 + 6 * lane);
                const f32x2_t w0 = wp[0], w1 = wp[1], w2 = wp[2];
#pragma unroll
                for (int i = 0; i < 8; ++i) { const int sl = (j + i) & 7; acc[i][0] += w0 * wn[sl][0]; acc[i][1] += w1 * wn[sl][1]; acc[i][2] += w2 * wn[sl][2]; }
            }
            float lg[6], lb[6];
#pragma unroll
            for (int k = 0; k < 6; ++k) { lg[k] = cln_g[6 * lane + k]; lb[k] = cln_b[6 * lane + k]; }
#pragma unroll
            for (int i = 0; i < 8; ++i) {
                float a[6] = {acc[i][0].x, acc[i][0].y, acc[i][1].x, acc[i][1].y, acc[i][2].x, acc[i][2].y};
                const float s = ((a[0] + a[1]) + (a[2] + a[3])) + (a[4] + a[5]);
                const float mean = wave_sum(s) * (1.0f / 384.0f);
                float s2 = 0.f;
#pragma unroll
                for (int k = 0; k < 6; ++k) { a[k] -= mean; s2 += a[k] * a[k]; }
                const float rstd = 1.0f / sqrtf(wave_sum(s2) * (1.0f / 384.0f) + EPS);
                float y[6];
#pragma unroll
                for (int k = 0; k < 6; ++k) { const float v = a[k] * rstd * lg[k] + lb[k]; y[k] = v / (1.0f + __expf(-v)); }
                unsigned* yo = (unsigned*)(Y + (size_t)(t0 + 8 * wave + i) * D + 384 + 6 * lane);
                yo[0] = pk2(y[0], y[1]); yo[1] = pk2(y[2], y[3]); yo[2] = pk2(y[4], y[5]);
            }
        }
    }
}

__global__ void __launch_bounds__(512, 2) mk_fwd(Args args) {
    extern __shared__ __attribute__((aligned(16))) unsigned char lds_raw[];
    LAS unsigned char* lds = (LAS unsigned char*)lds_raw;
    const int tid = threadIdx.x, lane = tid & 63, wave = __builtin_amdgcn_readfirstlane(tid >> 6);
    const int G = gridDim.x, bx = blockIdx.x;
    unsigned* barw = (unsigned*)args.ws;
    volatile LAS unsigned* bst = (volatile LAS unsigned*)(lds + LDS_BYTES - 16);
    if (tid < 2) bst[tid] = 0u;
    if (bx == 0) for (int i = tid; i < XCD_BAR_WORDS; i += 512) __hip_atomic_store(barw + i, 0u, __ATOMIC_RELAXED, __HIP_MEMORY_SCOPE_AGENT);
    __syncthreads();
    if (args.ph_lo == 0) { prologue_phase(args, lds, lane, wave, G, bx);
#if MK_PROBE == 1
        __syncthreads(); prologue_phase(args, lds, lane, wave, G, bx);
#endif
        if (args.ph_hi > 1) cg::this_grid().sync(); }
    XcdBarrier xbar = xcd_barrier_post(barw, bst);
    const int plo = args.ph_lo < 1 ? 1 : args.ph_lo, phi = args.ph_hi > NPHASE - 1 ? NPHASE - 1 : args.ph_hi;
#pragma unroll 1
    for (int ph = plo; ph < phi; ++ph) {
        int tid_ = threadIdx.x; asm volatile("" : "+v"(tid_));
        const int lane_ = tid_ & 63, wave_ = __builtin_amdgcn_readfirstlane(tid_ >> 6);
        unsigned char* wsp_ = args.ws; asm volatile("" : "+s"(wsp_));
        bf16_t* XB = (bf16_t*)(wsp_ + WS_XB); bf16_t* HB = (bf16_t*)(wsp_ + WS_H); bf16_t* ZB = (bf16_t*)(wsp_ + WS_Z); bf16_t* YB = (bf16_t*)(wsp_ + WS_Y);
        float* SSQ = (float*)(wsp_ + WS_SSQ);
        const int l = (ph - 1) / 7, s = (ph - 1) % 7;
        unsigned char* wl = wsp_ + WS_W + (size_t)l * W_LAYER;
        if (s == 0 || s == 5) {
            pg8::Gemm g{XB, (const bf16_t*)(wl + (s == 0 ? W_GU1 : W_GU2)), M, 2 * FF, D};
            pg8::StaticOrder S; S.init(M, 2 * FF, G, bx);
            pg8::EpiSwiGLU E{HB, FF, SSQ};
            pg8::gemm_phase<pg8::EpiSwiGLU, pg8::StaticOrder, true, true>(lds, g, S, E);
#if MK_PROBE == 4
            __syncthreads(); pg8::gemm_phase<pg8::EpiSwiGLU, pg8::StaticOrder, true, true>(lds, g, S, E);
#endif
        } else if (s == 1 || s == 6 || s == 4) {
            pg8::Gemm g{s == 4 ? YB : HB, (const bf16_t*)(wl + (s == 1 ? W_D1 : (s == 6 ? W_D2 : W_OUT))), M, D, s == 4 ? D : FF};
            pg8::StaticOrder S; S.init(M, D, G, bx);
            pg8::EpiRes E{(l == 0 && s == 1) ? args.in[0] : args.out, args.out, XB, SSQ};
            pg8::gemm_phase<pg8::EpiRes, pg8::StaticOrder, true, true>(lds, g, S, E);
        } else if (s == 2) {
            pg8::Gemm g{XB, (const bf16_t*)(wl + W_IN), M, DIN, D};
            pg8::StaticOrder S; S.init(M, DIN, G, bx);
            pg8::EpiWin E{ZB, ZLD, SSQ};
            pg8::gemm_phase<pg8::EpiWin, pg8::StaticOrder, true, true>(lds, g, S, E);
        } else {
            mixer_phase(lds, ZB, YB, args.in[7] + l * 384, args.in[8] + l * 384, args.in[9] + (size_t)l * 6 * 128 * 128, args.in[10] + l * 6 * 128,
                        args.in[11] + (size_t)l * 31 * 384, args.in[12] + l * 384, args.in[13] + l * 384, args.in[14] + l * 384,
                        args.in[15] + (size_t)l * 4 * 64 * 64, args.in[16] + l * 256, tid_, lane_, wave_, G, bx);
#if MK_PROBE == 2
            mixer_phase(lds, ZB, YB, args.in[7] + l * 384, args.in[8] + l * 384, args.in[9] + (size_t)l * 6 * 128 * 128, args.in[10] + l * 6 * 128,
                        args.in[11] + (size_t)l * 31 * 384, args.in[12] + l * 384, args.in[13] + l * 384, args.in[14] + l * 384,
                        args.in[15] + (size_t)l * 4 * 64 * 64, args.in[16] + l * 256, tid_, lane_, wave_, G, bx);
#endif
        }
        if (ph + 1 < args.ph_hi) { xcd_barrier(xbar);
#if MK_PROBE == 3
            xcd_barrier(xbar);
#endif
        }
    }
    if (args.ph_hi == NPHASE) final_phase(args, lane, wave, G, bx);
}

extern "C" void kernel_launch(void* const* d_in, const int* in_sizes, int n_in, void* d_out, int out_size, void* d_ws, size_t ws_size, hipStream_t stream) {
    static int grid = 0;
    if (grid == 0) {
        int dev = 0, cus = 0, per_cu = 0;
        hipGetDevice(&dev);
        hipDeviceGetAttribute(&cus, hipDeviceAttributeMultiprocessorCount, dev);
        if (hipFuncSetAttribute((const void*)mk_fwd, hipFuncAttributeMaxDynamicSharedMemorySize, LDS_BYTES) != hipSuccess) fprintf(stderr, "kernel_launch: hipFuncSetAttribute failed\n");
        if (hipOccupancyMaxActiveBlocksPerMultiprocessor(&per_cu, (const void*)mk_fwd, 512, LDS_BYTES) != hipSuccess || per_cu < 1) { fprintf(stderr, "kernel_launch: occupancy query says %d\n", per_cu); per_cu = 1; }
        (void)hipGetLastError();
        grid = cus * 1;
        if (grid <= 0) grid = 256;
    }
    Args a{};
    for (int i = 0; i < 23; ++i) a.in[i] = (const float*)d_in[i];
    a.out = (float*)d_out; a.ws = (unsigned char*)d_ws;
#if MK_PER_PHASE
    for (int ph = 0; ph < NPHASE; ++ph) { a.ph_lo = ph; a.ph_hi = ph + 1; hipLaunchKernelGGL(mk_fwd, dim3(grid), dim3(512), LDS_BYTES, stream, a); }
#else
    a.ph_lo = 0; a.ph_hi = NPHASE;
    void* kargs[] = {&a};
    const hipError_t e = hipLaunchCooperativeKernel((const void*)mk_fwd, dim3(grid), dim3(512), kargs, LDS_BYTES, stream);
    if (e != hipSuccess) fprintf(stderr, "kernel_launch: cooperative launch failed: %s (grid %d)\n", hipGetErrorString(e), grid);
#endif
}
```
